# Optimizing an MI355X kernel written in HIP

```python
import math
import jax, jax.numpy as jnp
from jax import lax
import numpy as np

D_MODEL = 2048
BATCH = 4
SEQ = 4096
DEPTH = 2

D_FF = 5632
SGU_WIDTH = D_MODEL // 2
SGU_GROUPS = 8
SGU_GROUP_CH = SGU_WIDTH // SGU_GROUPS
SGU_CHUNK = 128
ATT_HEADS = 8
ATT_HEAD_DIM = 128
ATT_WIDTH = ATT_HEADS * ATT_HEAD_DIM
IDX_HEADS = 16
IDX_DIM = 64
TOPK_MAX = 256
Q_BLOCK = 128
NUM_BUCKETS = 32
MAX_DISTANCE = 128
NORM_EPS = 1e-6
LN_EPS = 1e-5

IN_SIZES = (SGU_WIDTH, SGU_WIDTH, ATT_WIDTH, ATT_WIDTH, ATT_WIDTH,
            IDX_HEADS * IDX_DIM, IDX_DIM, IDX_HEADS)
IN_COLS = sum(IN_SIZES)
IN_SPLITS = tuple(int(s) for s in np.cumsum(IN_SIZES)[:-1])

kernel_name = "hybrid_gated_sgu_dsa_macaron"


def rmsnorm(x, g):
    xf = x.astype(jnp.float32)
    y = xf * lax.rsqrt(jnp.mean(xf * xf, axis=-1, keepdims=True) + NORM_EPS)
    return (y * g.astype(jnp.float32)).astype(x.dtype)


def layernorm(x, g, b):
    xf = x.astype(jnp.float32)
    mu = jnp.mean(xf, axis=-1, keepdims=True)
    var = jnp.mean(jnp.square(xf - mu), axis=-1, keepdims=True)
    y = (xf - mu) * lax.rsqrt(var + LN_EPS)
    return (y * g.astype(jnp.float32) + b.astype(jnp.float32)).astype(x.dtype)


def swiglu(h, w_in, w_out):
    a, b = jnp.split(h @ w_in, 2, axis=-1)
    return (jax.nn.silu(a) * b) @ w_out


def t5_causal_bucket(n):
    max_exact = NUM_BUCKETS // 2
    nf = jnp.maximum(n, 1).astype(jnp.float32)
    large = max_exact + (jnp.log(nf / max_exact) / math.log(MAX_DISTANCE / max_exact)
                         * (NUM_BUCKETS - max_exact)).astype(jnp.int32)
    large = jnp.minimum(large, NUM_BUCKETS - 1)
    return jnp.where(n < max_exact, n, large)


def spatial_gating(z_u, z_v, ln_g, ln_b, w_s, b_s):
    B, S, _ = z_v.shape
    n_chunks = S // SGU_CHUNK
    v = layernorm(z_v, ln_g, ln_b).reshape(B, n_chunks, SGU_CHUNK, SGU_GROUPS, SGU_GROUP_CH)
    causal = jnp.tril(jnp.ones((SGU_CHUNK, SGU_CHUNK), dtype=bool))
    ws = jnp.where(causal[None], w_s, jnp.zeros_like(w_s))
    mixed = jnp.einsum('gts,bnsgc->bntgc', ws, v) + b_s.T[None, None, :, :, None]
    return z_u * mixed.reshape(B, S, SGU_WIDTH)


def dsa_attention(q, k, v, q_idx, k_idx, w_idx, rel_bias):
    B, S = q.shape[0], q.shape[1]
    top_k = min(TOPK_MAX, S // 4)
    n_blocks = S // Q_BLOCK
    key_pos = jnp.arange(S, dtype=jnp.int32)
    idx_scale = IDX_DIM ** -0.5
    head_w_scale = IDX_HEADS ** -0.5
    att_scale = ATT_HEAD_DIM ** -0.5

    def to_blocks(a):
        return jnp.moveaxis(a.reshape(B, n_blocks, Q_BLOCK, *a.shape[2:]), 1, 0)

    gather = jax.vmap(lambda table, ids: table[ids])

    def block(args):
        qb, qib, wb, start = args
        q_pos = start + jnp.arange(Q_BLOCK, dtype=jnp.int32)
        causal = key_pos[None, :] <= q_pos[:, None]
        dots = jnp.einsum('bthd,bsd->bths', qib, k_idx).astype(jnp.float32) * idx_scale
        score = jnp.einsum('bths,bth->bts', jax.nn.relu(dots), wb.astype(jnp.float32) * head_w_scale)
        score = jnp.where(causal[None], score, -jnp.inf)
        _, sel = lax.top_k(score, top_k)
        k_sel = gather(k, sel)
        v_sel = gather(v, sel)
        dist = q_pos[None, :, None] - sel
        valid = dist >= 0
        bias = rel_bias[t5_causal_bucket(jnp.maximum(dist, 0))]
        logits = jnp.einsum('bthd,btkhd->bthk', qb, k_sel).astype(jnp.float32) * att_scale
        logits = logits + jnp.moveaxis(bias.astype(jnp.float32), -1, 2)
        logits = jnp.where(valid[:, :, None, :], logits, -jnp.inf)
        p = jax.nn.softmax(logits, axis=-1).astype(v.dtype)
        return jnp.einsum('bthk,btkhd->bthd', p, v_sel)

    starts = jnp.arange(n_blocks, dtype=jnp.int32) * Q_BLOCK
    out = lax.map(block, (to_blocks(q), to_blocks(q_idx), to_blocks(w_idx), starts))
    return jnp.moveaxis(out, 0, 1).reshape(B, S, ATT_WIDTH)


def setup_inputs(seed: int = 0) -> dict:
    key = jax.random.key(seed)
    ks = jax.random.split(key, 24)
    f32 = jnp.float32

    def w(k, shape, fan_in):
        return jax.random.normal(k, shape, f32) * fan_in ** -0.5

    def gain(k, shape):
        return 1.0 + 0.02 * jax.random.normal(k, shape, f32)

    L = DEPTH
    return {
        "x": jax.random.normal(ks[0], (BATCH, SEQ, D_MODEL), f32),
        "ffn1_norm_pre": gain(ks[1], (L, D_MODEL)),
        "ffn1_norm_post": gain(ks[2], (L, D_MODEL)),
        "ffn1_w_in": w(ks[3], (L, D_MODEL, 2 * D_FF), D_MODEL),
        "ffn1_w_out": w(ks[4], (L, D_FF, D_MODEL), D_FF),
        "mix_norm_pre": gain(ks[5], (L, D_MODEL)),
        "mix_norm_post": gain(ks[6], (L, D_MODEL)),
        "w_in": w(ks[7], (L, D_MODEL, IN_COLS), D_MODEL),
        "sgu_ln_g": gain(ks[8], (L, SGU_WIDTH)),
        "sgu_ln_b": 0.02 * jax.random.normal(ks[9], (L, SGU_WIDTH), f32),
        "sgu_w_s": w(ks[10], (L, SGU_GROUPS, SGU_CHUNK, SGU_CHUNK), SGU_CHUNK),
        "sgu_b": gain(ks[11], (L, SGU_GROUPS, SGU_CHUNK)),
        "rel_bias": 0.5 * jax.random.normal(ks[12], (NUM_BUCKETS, ATT_HEADS), f32),
        "w_branch_a": w(ks[13], (L, SGU_WIDTH, D_MODEL), SGU_WIDTH),
        "w_branch_b": w(ks[14], (L, ATT_WIDTH, D_MODEL), ATT_WIDTH),
        "w_gate": w(ks[15], (L, D_MODEL, 2 * D_MODEL), D_MODEL),
        "w_out": w(ks[16], (L, D_MODEL, D_MODEL), D_MODEL),
        "ffn2_norm_pre": gain(ks[17], (L, D_MODEL)),
        "ffn2_norm_post": gain(ks[18], (L, D_MODEL)),
        "ffn2_w_in": w(ks[19], (L, D_MODEL, 2 * D_FF), D_MODEL),
        "ffn2_w_out": w(ks[20], (L, D_FF, D_MODEL), D_FF),
    }


def reference(x, ffn1_norm_pre, ffn1_norm_post, ffn1_w_in, ffn1_w_out,
              mix_norm_pre, mix_norm_post, w_in, sgu_ln_g, sgu_ln_b, sgu_w_s, sgu_b,
              rel_bias, w_branch_a, w_branch_b, w_gate, w_out,
              ffn2_norm_pre, ffn2_norm_post, ffn2_w_in, ffn2_w_out):
    B, S, _ = x.shape
    for l in range(DEPTH):
        f = swiglu(rmsnorm(x, ffn1_norm_pre[l]), ffn1_w_in[l], ffn1_w_out[l])
        x = x + 0.5 * rmsnorm(f, ffn1_norm_post[l])

        h = rmsnorm(x, mix_norm_pre[l])
        z_u, z_v, q, k, v, q_idx, k_idx, w_idx = jnp.split(h @ w_in[l], IN_SPLITS, axis=-1)

        y_a = spatial_gating(jax.nn.gelu(z_u), jax.nn.gelu(z_v),
                             sgu_ln_g[l], sgu_ln_b[l], sgu_w_s[l], sgu_b[l])

        y_b = dsa_attention(q.reshape(B, S, ATT_HEADS, ATT_HEAD_DIM),
                            k.reshape(B, S, ATT_HEADS, ATT_HEAD_DIM),
                            v.reshape(B, S, ATT_HEADS, ATT_HEAD_DIM),
                            q_idx.reshape(B, S, IDX_HEADS, IDX_DIM),
                            k_idx, w_idx, rel_bias)

        g_a, g_b = jnp.split(jax.nn.sigmoid(h @ w_gate[l]), 2, axis=-1)
        merged = g_a * (y_a @ w_branch_a[l]) + g_b * (y_b @ w_branch_b[l])
        x = x + rmsnorm(merged @ w_out[l], mix_norm_post[l])

        f = swiglu(rmsnorm(x, ffn2_norm_pre[l]), ffn2_w_in[l], ffn2_w_out[l])
        x = x + 0.5 * rmsnorm(f, ffn2_norm_post[l])
    return x
```

```cpp
#include <hip/hip_runtime.h>
#include <cstdio>
#include <cstdint>

#define DUP_IDX 1
#define DUP_SGU 1
#ifndef DUP_MASK
#define DUP_MASK 0x0
#endif
#define PH_REP(k) (((DUP_MASK >> (k)) & 1) ? 2 : 1)
#ifndef SKIP_MASK
#define SKIP_MASK 0x0
#endif
#define PH_ON(k) (!((SKIP_MASK >> (k)) & 1))
#ifndef MK_N_LAUNCHES
#define MK_N_LAUNCHES 1
#endif

#define LAS __attribute__((address_space(3)))
#define GAS __attribute__((address_space(1)))
typedef unsigned short bf16_t;
typedef short bf16x8 __attribute__((ext_vector_type(8)));
typedef short s16x4 __attribute__((ext_vector_type(4)));
typedef float f32x4 __attribute__((ext_vector_type(4)));
typedef float f32x2 __attribute__((ext_vector_type(2)));
typedef float f32x16 __attribute__((ext_vector_type(16)));
typedef unsigned u32x4 __attribute__((ext_vector_type(4)));
typedef unsigned u32x2 __attribute__((ext_vector_type(2)));

constexpr int NB = 4, SEQ = 4096, DM = 2048, DEPTH = 2, FF = 5632, NFF = 2 * FF;
constexpr int MT = NB * SEQ;
constexpr int SGW = 1024, NHEAD = 8, HD = 128, TOPK = 256;
constexpr int INCOLS = 6224;
constexpr int LDZ = 10496;
constexpr int ZU = 0, ZV = 1024, ZQ = 2048, ZK = 3072, ZVV = 4096, ZQI = 5120, ZKI = 6144, ZWI = 6208, ZG = 6400;
constexpr float NORM_EPS = 1e-6f, LN_EPS = 1e-5f;
#ifndef F8_MASK
#define F8_MASK 0xE
#endif
__host__ __device__ constexpr bool f8_on(int l, int i) { return (F8_MASK >> (2 * l + i)) & 1; }
#ifndef I8_MASK
#define I8_MASK 0x3F
#endif
constexpr float I8_WCLIP = 0.0884f, I8_SWQ = 127.f / I8_WCLIP;
constexpr float F8_SG = 8.f, F8_SW = 4096.f;

constexpr size_t MiB = 1u << 20;
constexpr size_t WS_CTL = 0, CTL_BYTES = 1 * MiB;
constexpr size_t WS_WF1I = 1 * MiB;
constexpr size_t WS_WF1O = WS_WF1I + 44 * MiB;
constexpr size_t WS_WF2I = WS_WF1O + 22 * MiB;
constexpr size_t WS_WF2O = WS_WF2I + 44 * MiB;
constexpr size_t WS_WMIX = WS_WF2O + 22 * MiB;
constexpr size_t WS_WA = WS_WMIX + 41 * MiB;
constexpr size_t WS_WB = WS_WA + 4 * MiB;
constexpr size_t WS_WO = WS_WB + 4 * MiB;
constexpr size_t WS_H = WS_WO + 8 * MiB;
constexpr size_t WS_F = WS_H + 64 * MiB;
constexpr size_t WS_Z = WS_F + 64 * MiB;
constexpr size_t WS_YA = WS_Z + 328 * MiB;
constexpr size_t WS_YB = WS_YA + 32 * MiB;
constexpr size_t WS_MASK = WS_YB + 32 * MiB;
constexpr size_t WS_WSB = WS_MASK + 8 * MiB;
constexpr size_t WS_XB = WS_WSB + 1 * MiB;
constexpr size_t WS_RS = WS_XB + 64 * MiB;
constexpr size_t WS_END = WS_RS + 1 * MiB;
constexpr int CW_BAR = 4096;

constexpr int RING_BYTES = 131072, LDSCTL_OFF = RING_BYTES, MISC_OFF = LDSCTL_OFF + 320, LDS_BYTES = 147456;
constexpr int RSL_OFF = LDSCTL_OFF + 4096;
constexpr int NWAVES = 8;

#define LDS_WAIT() asm volatile("s_waitcnt lgkmcnt(0)" ::: "memory")
#define VM_WAIT() asm volatile("s_waitcnt vmcnt(0)" ::: "memory")

typedef __bf16 bf16x2_t __attribute__((ext_vector_type(2)));
__device__ __forceinline__ unsigned cvt_pk_bf16(float lo, float hi) { f32x2 v = {lo, hi}; bf16x2_t r = __builtin_convertvector(v, bf16x2_t); return __builtin_bit_cast(unsigned, r); }
__device__ __forceinline__ float bf_lo(unsigned w) { return __uint_as_float(w << 16); }
__device__ __forceinline__ float bf_hi(unsigned w) { return __uint_as_float(w & 0xffff0000u); }
__device__ __forceinline__ float sigmoidf_(float x) { return __builtin_amdgcn_rcpf(1.0f + __builtin_amdgcn_exp2f(-1.4426950408889634f * x)); }
__device__ __forceinline__ float siluf_(float x) { return x * sigmoidf_(x); }
__device__ __forceinline__ float gelu_tanhf_(float x) { return x * sigmoidf_(1.5957691216057308f * (x + 0.044715f * x * x * x)); }
__device__ __forceinline__ float shx_f(float v, int o, int lane) { return __int_as_float(__builtin_amdgcn_ds_bpermute((lane ^ o) << 2, __float_as_int(v))); }
__device__ __forceinline__ unsigned shx_u(unsigned v, int o, int lane) { return (unsigned)__builtin_amdgcn_ds_bpermute((lane ^ o) << 2, (int)v); }
#define WR_DPP(v, ctl) __int_as_float(__builtin_amdgcn_update_dpp(0, __float_as_int(v), ctl, 0xF, 0xF, true))
__device__ __forceinline__ float wave_sum(float v, int) {
    v += WR_DPP(v, 0xB1); v += WR_DPP(v, 0x4E); v += WR_DPP(v, 0x141); v += WR_DPP(v, 0x140);
    { auto r = __builtin_amdgcn_permlane16_swap(__float_as_uint(v), __float_as_uint(v), false, false); v = __uint_as_float(r[0]) + __uint_as_float(r[1]); }
    { auto r = __builtin_amdgcn_permlane32_swap(__float_as_uint(v), __float_as_uint(v), false, false); v = __uint_as_float(r[0]) + __uint_as_float(r[1]); }
    return v;
}
__device__ __forceinline__ float wave_max(float v) {
    v = fmaxf(v, WR_DPP(v, 0xB1)); v = fmaxf(v, WR_DPP(v, 0x4E)); v = fmaxf(v, WR_DPP(v, 0x141)); v = fmaxf(v, WR_DPP(v, 0x140));
    { auto r = __builtin_amdgcn_permlane16_swap(__float_as_uint(v), __float_as_uint(v), false, false); v = fmaxf(__uint_as_float(r[0]), __uint_as_float(r[1])); }
    { auto r = __builtin_amdgcn_permlane32_swap(__float_as_uint(v), __float_as_uint(v), false, false); v = fmaxf(__uint_as_float(r[0]), __uint_as_float(r[1])); }
    return v;
}
#undef WR_DPP

namespace pg8 {
constexpr int BM = 256, BK = 64, HALF = 128, HTB = HALF * BK * 2, STAGE_BYTES = 8 * HTB, NXCD = 8, WGM = 8;
__host__ __device__ __forceinline__ int lds_byte(int r, int c) { const int st = (r >> 4) * 2 + (c >> 5), rr = r & 15, cc = c & 31, ob = rr * 64 + cc * 2; return st * 1024 + (ob ^ (((ob >> 9) & 1) << 5)); }
__host__ __device__ __forceinline__ void stage_rc(int b, int& R, int& C) { const int st = b / 1024, sb = b % 1024, swz = sb ^ (((sb >> 9) & 1) << 5); R = (st >> 1) * 16 + swz / 64; C = (st & 1) * 32 + (swz % 64) / 2; }
__host__ __device__ __forceinline__ int perm32(int rho) { const int n = rho >> 4, i = rho & 15; return 8 * (i >> 2) + 4 * n + (i & 3); }
struct Unit { int pm, pn; };
struct Gemm { const bf16_t* A; const bf16_t* Bt; int M, N, K; };
struct StaticOrder {
    int nM, nN, nwg, G, c;
    __host__ __device__ void init(int M, int N, int G_, int c_) { nM = M / BM; nN = N / BM; nwg = nM * nN; G = G_; c = c_; }
    __host__ __device__ bool next(int i, Unit& u) const {
        const long L = (long)i * G + c; if (L >= nwg) return false;
        int wgid = (int)L; { const int q = nwg / NXCD, r = nwg % NXCD, xcd = wgid % NXCD, off = wgid / NXCD; wgid = (xcd < r ? xcd * (q + 1) : r * (q + 1) + (xcd - r) * q) + off; }
        const int nig = WGM * nN, gid = wgid / nig, fm = gid * WGM, gsz = (nM - fm) < WGM ? (nM - fm) : WGM;
        u.pm = fm + ((wgid % nig) % gsz); u.pn = (wgid % nig) / gsz; return true;
    }
    __device__ __forceinline__ void a_ready(const Unit&) const {}
    __device__ __forceinline__ void done(const Unit&) const {}
};

template <int MODE, bool IACC = false> struct Epi {
    static __device__ __forceinline__ f32x4 ld(const f32x4& a) { if constexpr (IACC) { return (f32x4){(float)__float_as_int(a[0]), (float)__float_as_int(a[1]), (float)__float_as_int(a[2]), (float)__float_as_int(a[3])}; } else { return a; } }
    static constexpr bool PERM = true, AFTER_DRAIN = false;
    bf16_t* O; int ldc; const bf16_t* G; int ldg; const float* rs; float sc; float dq;
    struct Pre { float rsv[2][4]; };
    static constexpr bool USES_RS = (MODE == 1 || MODE == 2 || MODE == 5);
    __device__ __forceinline__ void prefetch(Pre& P, const LAS float* rsl, int wr, int fr) const {
        if constexpr (USES_RS) {
#pragma unroll
            for (int ai = 0; ai < 2; ++ai)
#pragma unroll
                for (int m = 0; m < 4; ++m) P.rsv[ai][m] = rsl[ai * HALF + wr * 64 + m * 16 + fr];
        }
    }
    template <int ACT> __device__ __forceinline__ void store_mix(const f32x4 (&acc)[2][2][4][2], const Pre& P, int row0, int col0, int kvh = -1, float osc = 1.f) const {
        constexpr float C0 = -1.5957691216057308f * 1.4426950408889634f, C1 = 0.044715f * C0;
#pragma unroll
        for (int ai = 0; ai < 2; ++ai)
#pragma unroll
            for (int m = 0; m < 4; ++m) {
                const size_t row = (size_t)(row0 + ai * HALF + m * 16);
                const float rsv = P.rsv[ai][m] * dq * osc, k2 = rsv * -1.4426950408889634f;
#pragma unroll
                for (int bj = 0; bj < 2; ++bj) {
                    f32x4 v0 = ld(acc[ai][bj][m][0]), v1 = ld(acc[ai][bj][m][1]);
                    if constexpr (ACT == 2) {
#pragma unroll
                        for (int j = 0; j < 4; ++j) { v0[j] = __builtin_amdgcn_rcpf(1.0f + __builtin_amdgcn_exp2f(v0[j] * k2)); v1[j] = __builtin_amdgcn_rcpf(1.0f + __builtin_amdgcn_exp2f(v1[j] * k2)); }
                    } else {
                        v0 = v0 * rsv; v1 = v1 * rsv;
                        if constexpr (ACT == 1) {
#pragma unroll
                            for (int j = 0; j < 4; ++j) {
                                { const float x = v0[j]; v0[j] = x * __builtin_amdgcn_rcpf(1.0f + __builtin_amdgcn_exp2f(x * fmaf(x * x, C1, C0))); }
                                { const float x = v1[j]; v1[j] = x * __builtin_amdgcn_rcpf(1.0f + __builtin_amdgcn_exp2f(x * fmaf(x * x, C1, C0))); } }
                        }
                    }
                    u32x4 w; w.x = cvt_pk_bf16(v0[0], v0[1]); w.y = cvt_pk_bf16(v0[2], v0[3]); w.z = cvt_pk_bf16(v1[0], v1[1]); w.w = cvt_pk_bf16(v1[2], v1[3]);
                    if (ACT == 0 && kvh >= 0) {
                        const size_t b_ = row >> 12, t_ = row & 4095;
                        *(u32x4*)(const_cast<bf16_t*>(G) + (((size_t)(kvh >> 3) * NB + b_) * NHEAD + (size_t)((kvh & 7) + bj)) * ((size_t)SEQ * 128) + t_ * 128 + (col0 & 127)) = w;
                    } else *(u32x4*)(O + row * ldc + col0 + bj * HALF) = w;
                }
            }
    }
    __device__ __forceinline__ void operator()(const f32x4 (&acc)[2][2][4][2], const Unit& u, int wr, int wc, int fr, int fq, const Pre& P) const {
        const int row0 = u.pm * BM + wr * 64 + fr;
        if constexpr (MODE == 5) {
            const int col0 = u.pn * HALF + wc * 32 + 8 * fq;
            unsigned char* Ob = (unsigned char*)O;
#pragma unroll
            for (int ai = 0; ai < 2; ++ai)
#pragma unroll
                for (int m = 0; m < 4; ++m) {
                    const float rsv = P.rsv[ai][m] * dq, k2 = rsv * -1.4426950408889634f, c2 = rsv * rsv * sc;
                    const f32x4 a0 = ld(acc[ai][0][m][0]), a1 = ld(acc[ai][0][m][1]), b0 = ld(acc[ai][1][m][0]), b1 = ld(acc[ai][1][m][1]);
                    float v[8];
#pragma unroll
                    for (int j = 0; j < 4; ++j) {
                        v[j] = (a0[j] * b0[j]) * (c2 * __builtin_amdgcn_rcpf(1.0f + __builtin_amdgcn_exp2f(a0[j] * k2)));
                        v[4 + j] = (a1[j] * b1[j]) * (c2 * __builtin_amdgcn_rcpf(1.0f + __builtin_amdgcn_exp2f(a1[j] * k2))); }
#pragma unroll
                    for (int j = 0; j < 8; ++j) v[j] = __builtin_amdgcn_fmed3f(v[j], -448.f, 448.f);
                    int w0 = 0, w1 = 0;
                    w0 = __builtin_amdgcn_cvt_pk_fp8_f32(v[0], v[1], w0, false); w0 = __builtin_amdgcn_cvt_pk_fp8_f32(v[2], v[3], w0, true);
                    w1 = __builtin_amdgcn_cvt_pk_fp8_f32(v[4], v[5], w1, false); w1 = __builtin_amdgcn_cvt_pk_fp8_f32(v[6], v[7], w1, true);
                    *(u32x2*)(Ob + (size_t)(row0 + ai * HALF + m * 16) * ldc + col0) = (u32x2){(unsigned)w0, (unsigned)w1};
                }
        } else if constexpr (MODE == 1) {
            const int col0 = u.pn * HALF + wc * 32 + 8 * fq;
#pragma unroll
            for (int ai = 0; ai < 2; ++ai)
#pragma unroll
                for (int m = 0; m < 4; ++m) {
                    bf16_t* rowp = O + (size_t)(row0 + ai * HALF + m * 16) * ldc + col0;
                    const float rsv = P.rsv[ai][m] * dq, k2 = rsv * -1.4426950408889634f, c2 = rsv * rsv;
                    const f32x4 a0 = ld(acc[ai][0][m][0]), a1 = ld(acc[ai][0][m][1]), b0 = ld(acc[ai][1][m][0]), b1 = ld(acc[ai][1][m][1]);
                    float v[8];
#pragma unroll
                    for (int j = 0; j < 4; ++j) {
                        v[j] = (a0[j] * b0[j]) * (c2 * __builtin_amdgcn_rcpf(1.0f + __builtin_amdgcn_exp2f(a0[j] * k2)));
                        v[4 + j] = (a1[j] * b1[j]) * (c2 * __builtin_amdgcn_rcpf(1.0f + __builtin_amdgcn_exp2f(a1[j] * k2))); }
                    u32x4 w;
                    w.x = cvt_pk_bf16(v[0], v[1]); w.y = cvt_pk_bf16(v[2], v[3]); w.z = cvt_pk_bf16(v[4], v[5]); w.w = cvt_pk_bf16(v[6], v[7]);
                    *(u32x4*)rowp = w;
                }
        } else {
            const int col0 = u.pn * BM + wc * 32 + 8 * fq;
            if constexpr (MODE == 2) { if (u.pn < 8) store_mix<1>(acc, P, row0, col0); else if (u.pn >= 25) store_mix<2>(acc, P, row0, col0); else store_mix<0>(acc, P, row0, col0, (G != nullptr && u.pn >= 12 && u.pn < 20) ? 2 * (u.pn - 12) : -1, (u.pn >= 8 && u.pn < 12) ? 0.12751743f : 1.f); return; }
#pragma unroll
            for (int ai = 0; ai < 2; ++ai) {
                u32x4 gv[4][2], ov[4][2];
                if constexpr (MODE == 3 || MODE == 4) {
#pragma unroll
                    for (int m = 0; m < 4; ++m)
#pragma unroll
                        for (int bj = 0; bj < 2; ++bj) { const size_t row = (size_t)(row0 + ai * HALF + m * 16);
                            gv[m][bj] = *(const u32x4*)(G + row * ldg + col0 + bj * HALF);
                            if constexpr (MODE == 4) ov[m][bj] = *(const u32x4*)(O + row * ldc + col0 + bj * HALF); }
                }
#pragma unroll
                for (int m = 0; m < 4; ++m) {
                    const size_t row = (size_t)(row0 + ai * HALF + m * 16);
#pragma unroll
                    for (int bj = 0; bj < 2; ++bj) {
                        f32x4 v0 = ld(acc[ai][bj][m][0]), v1 = ld(acc[ai][bj][m][1]);
                        bf16_t* op = O + row * ldc + col0 + bj * HALF;
                        if constexpr (MODE == 0) { v0 = v0 * sc; v1 = v1 * sc; }
                        if constexpr (MODE == 3 || MODE == 4) {
                            const u32x4 g = gv[m][bj];
                            v0[0] *= bf_lo(g.x); v0[1] *= bf_hi(g.x); v0[2] *= bf_lo(g.y); v0[3] *= bf_hi(g.y);
                            v1[0] *= bf_lo(g.z); v1[1] *= bf_hi(g.z); v1[2] *= bf_lo(g.w); v1[3] *= bf_hi(g.w);
                        }
                        if constexpr (MODE == 4) {
                            const u32x4 o = ov[m][bj];
                            v0[0] += bf_lo(o.x); v0[1] += bf_hi(o.x); v0[2] += bf_lo(o.y); v0[3] += bf_hi(o.y);
                            v1[0] += bf_lo(o.z); v1[1] += bf_hi(o.z); v1[2] += bf_lo(o.w); v1[3] += bf_hi(o.w);
                        }
                        u32x4 w; w.x = cvt_pk_bf16(v0[0], v0[1]); w.y = cvt_pk_bf16(v0[2], v0[3]); w.z = cvt_pk_bf16(v1[0], v1[1]); w.w = cvt_pk_bf16(v1[2], v1[3]);
                        *(u32x4*)op = w;
                    }
                }
            }
        }
    }
};

typedef int i32x4 __attribute__((ext_vector_type(4)));
typedef int i32x8 __attribute__((ext_vector_type(8)));
__device__ __forceinline__ i32x8 cat8(bf16x8 lo, bf16x8 hi) { const i32x4 a = __builtin_bit_cast(i32x4, lo), b = __builtin_bit_cast(i32x4, hi); return __builtin_shufflevector(a, b, 0, 1, 2, 3, 4, 5, 6, 7); }
template <class EpiT, class Sched, bool ALIGN_EPI = false, bool SP2 = false, int OPK = 0>
__device__ __forceinline__ void gemm_phase(LAS unsigned char* lds, const Gemm g, const Sched& S, const EpiT& E, const int tid) {
    const int wid = __builtin_amdgcn_readfirstlane(tid >> 6), lane = tid & 63, wr = wid >> 2, wc = wid & 3, fr = lane & 15, fq = lane >> 4;
    constexpr bool F8 = OPK == 1, I8 = OPK == 2;
    const int K = g.K, RB = (F8 || I8) ? K : 2 * K, nt = RB / (BK * 2);
    unsigned voffA[2], voffB[2];
#pragma unroll
    for (int i = 0; i < 2; ++i) { int R, C; stage_rc(tid * 16 + i * 8192, R, C); const int Rb = EpiT::PERM ? ((R & ~31) + perm32(R & 31)) : R;
        voffA[i] = (unsigned)(R * RB + C * 2); voffB[i] = (unsigned)(Rb * RB + C * 2); }
    const size_t kstep = (size_t)(BK * 2);
    const size_t hstep = (size_t)HALF * RB;
    const size_t tstep = 2 * hstep;
    const unsigned ldsw = (unsigned)wid * 1024u;
    const int aoff = lds_byte(wr * 64 + fr, fq * 8), boff = lds_byte(wc * 32 + fr, fq * 8);
#define PG8_SA(b, h) (((b) * 2 + (h)) * HTB)
#define PG8_SB(b, h) ((4 + (b) * 2 + (h)) * HTB)
#define PG8_STAGE(bufoff, gbase, voff) do { _Pragma("unroll") for (int _i = 0; _i < 2; ++_i) \
        __builtin_amdgcn_global_load_lds((const unsigned*)((const char*)(gbase) + (voff)[_i]), (LAS unsigned*)(lds + (bufoff) + ldsw + _i * 8192), 16, 0, 0); } while (0)
#define PG8_LDA(dst, b, h) do { _Pragma("unroll") for (int m = 0; m < 4; ++m) _Pragma("unroll") for (int k = 0; k < 2; ++k) dst[m][k] = *(const LAS bf16x8*)(lds + PG8_SA(b, h) + aoff + m * 2048 + k * 1024); } while (0)
#define PG8_LDB(dst, b, h) do { _Pragma("unroll") for (int n = 0; n < 2; ++n) _Pragma("unroll") for (int k = 0; k < 2; ++k) dst[n][k] = *(const LAS bf16x8*)(lds + PG8_SB(b, h) + boff + n * 2048 + k * 1024); } while (0)
#define PG8_MMA(ai, bj, At, Bt, Z) do { __builtin_amdgcn_s_setprio(1); _Pragma("unroll") for (int m = 0; m < 4; ++m) _Pragma("unroll") for (int n = 0; n < 2; ++n) { \
        if constexpr (F8) { const i32x8 b8_ = cat8(Bt[n][0], Bt[n][1]), a8_ = cat8(At[m][0], At[m][1]); \
            if constexpr (Z) asm volatile("v_mfma_f32_16x16x128_f8f6f4 %0, %1, %2, 0" : "=&v"(acc[ai][bj][m][n]) : "v"(b8_), "v"(a8_)); \
            else asm volatile("v_mfma_f32_16x16x128_f8f6f4 %0, %1, %2, %0" : "+v"(acc[ai][bj][m][n]) : "v"(b8_), "v"(a8_)); }     \
        else if constexpr (I8) { const i32x4 b40_ = __builtin_bit_cast(i32x4, Bt[n][0]), a40_ = __builtin_bit_cast(i32x4, At[m][0]), b41_ = __builtin_bit_cast(i32x4, Bt[n][1]), a41_ = __builtin_bit_cast(i32x4, At[m][1]); \
            if constexpr (Z) asm volatile("v_mfma_i32_16x16x64_i8 %0, %1, %2, 0" : "=&v"(acc[ai][bj][m][n]) : "v"(b40_), "v"(a40_)); \
            else asm volatile("v_mfma_i32_16x16x64_i8 %0, %1, %2, %0" : "+v"(acc[ai][bj][m][n]) : "v"(b40_), "v"(a40_)); \
            asm volatile("v_mfma_i32_16x16x64_i8 %0, %1, %2, %0" : "+v"(acc[ai][bj][m][n]) : "v"(b41_), "v"(a41_)); }     \
        else { acc[ai][bj][m][n] = __builtin_amdgcn_mfma_f32_16x16x32_bf16(Bt[n][0], At[m][0], acc[ai][bj][m][n], 0, 0, 0);     \
            acc[ai][bj][m][n] = __builtin_amdgcn_mfma_f32_16x16x32_bf16(Bt[n][1], At[m][1], acc[ai][bj][m][n], 0, 0, 0); } } \
        __builtin_amdgcn_s_setprio(0); } while (0)
#define PG8_WAIT_V(n) asm volatile("s_waitcnt vmcnt(" #n ")" ::: "memory")
#define PG8_WAIT_L(n) asm volatile("s_waitcnt lgkmcnt(" #n ")" ::: "memory")
#define PG8_BAR __builtin_amdgcn_s_barrier()
#define PG8_SCHED __builtin_amdgcn_sched_barrier(0)
    Unit cur, nxt; int ui = 0;
    if (!S.next(0, cur)) return;
    f32x4 acc[2][2][4][2];
#define PG8_ZERO() do { if constexpr (!(F8 || I8)) { _Pragma("unroll") for (int a = 0; a < 2; ++a) _Pragma("unroll") for (int b = 0; b < 2; ++b) _Pragma("unroll") for (int m = 0; m < 4; ++m) _Pragma("unroll") for (int n = 0; n < 2; ++n) acc[a][b][m][n] = (f32x4){0.f, 0.f, 0.f, 0.f}; } } while (0)
    PG8_ZERO();
    bf16x8 At[4][2], B0[2][2], B1[2][2];
    const char* cA = (const char*)g.A + (size_t)cur.pm * tstep; const char* cB = (const char*)g.Bt + (size_t)cur.pn * tstep;
    S.a_ready(cur);
    if constexpr (SP2) {
        PG8_STAGE(PG8_SB(0, 0), cB, voffB); PG8_STAGE(PG8_SB(0, 1), cB + hstep, voffB); PG8_STAGE(PG8_SA(0, 0), cA, voffA); PG8_STAGE(PG8_SA(0, 1), cA + hstep, voffA);
        if (wr == 1) PG8_BAR;
        PG8_WAIT_V(2); PG8_BAR;
        PG8_STAGE(PG8_SB(1, 0), cB + kstep, voffB); PG8_STAGE(PG8_SA(1, 0), cA + kstep, voffA); PG8_STAGE(PG8_SB(1, 1), cB + hstep + kstep, voffB);
        PG8_WAIT_V(6); PG8_BAR;
    } else {
        PG8_STAGE(PG8_SB(0, 0), cB, voffB); PG8_STAGE(PG8_SA(0, 0), cA, voffA); PG8_STAGE(PG8_SB(0, 1), cB + hstep, voffB); PG8_STAGE(PG8_SA(0, 1), cA + hstep, voffA);
        if (wr == 1) PG8_BAR;
        PG8_WAIT_V(4); PG8_BAR;
        PG8_STAGE(PG8_SB(1, 0), cB + kstep, voffB); PG8_STAGE(PG8_SA(1, 0), cA + kstep, voffA); PG8_STAGE(PG8_SB(1, 1), cB + hstep + kstep, voffB);
        PG8_WAIT_V(6); PG8_BAR;
    }
    for (;;) {
        const bool has_next = S.next(ui + 1, nxt);
        const char* nA = has_next ? (const char*)g.A + (size_t)nxt.pm * tstep : cA; const char* nB = has_next ? (const char*)g.Bt + (size_t)nxt.pn * tstep : cB;
        static_assert(SP2, "only the two-superphase K-loop is kept");
#define PG8_ITER(Z) do {                                                                                                                           \
            const bool last = (t == nt - 2);                                                                                                        \
            const char* a1 = cA + (size_t)(t + 1) * kstep;                                                                                          \
            const char* a2 = last ? nA : cA + (size_t)(t + 2) * kstep; const char* b2 = last ? nB : cB + (size_t)(t + 2) * kstep;                    \
            const char* a3 = a2 + kstep; const char* b3 = b2 + kstep;                                                                               \
            if (last && has_next) S.a_ready(nxt);                                                                                                   \
            if constexpr (EpiT::USES_RS) { if (last && wid < 4) { int tl_ = tid; asm volatile("" : "+v"(tl_));     \
                __builtin_amdgcn_global_load_lds((const unsigned*)(E.rs + (size_t)cur.pm * BM + wid * 64 + (tl_ & 63)), (LAS unsigned*)(lds + RSL_OFF + wid * 256), 4, 0, 0); } }   \
            PG8_LDB(B0, 0, 0); PG8_LDB(B1, 0, 1); PG8_SCHED; PG8_LDA(At, 0, 0); PG8_STAGE(PG8_SA(1, 1), a1 + hstep, voffA);                          \
            PG8_WAIT_V(8); PG8_WAIT_L(0); PG8_BAR; PG8_MMA(0, 0, At, B0, Z); PG8_MMA(0, 1, At, B1, Z); PG8_BAR; PG8_SCHED;                          \
            PG8_LDA(At, 0, 1); PG8_STAGE(PG8_SB(0, 0), b2, voffB); PG8_STAGE(PG8_SB(0, 1), b2 + hstep, voffB); PG8_STAGE(PG8_SA(0, 0), a2, voffA);   \
            PG8_WAIT_V(8); PG8_WAIT_L(0); PG8_BAR; PG8_MMA(1, 0, At, B0, Z); PG8_MMA(1, 1, At, B1, Z); PG8_BAR; PG8_SCHED;                          \
            PG8_LDB(B0, 1, 0); PG8_LDB(B1, 1, 1); PG8_SCHED; PG8_LDA(At, 1, 0); PG8_STAGE(PG8_SA(0, 1), a2 + hstep, voffA);                          \
            PG8_WAIT_V(8); PG8_WAIT_L(0); PG8_BAR; PG8_MMA(0, 0, At, B0, false); PG8_MMA(0, 1, At, B1, false); PG8_BAR; PG8_SCHED;                  \
            PG8_LDA(At, 1, 1); PG8_STAGE(PG8_SB(1, 0), b3, voffB); PG8_STAGE(PG8_SB(1, 1), b3 + hstep, voffB); PG8_STAGE(PG8_SA(1, 0), a3, voffA);   \
            PG8_WAIT_V(8); PG8_WAIT_L(0); PG8_BAR; PG8_MMA(1, 0, At, B0, false); PG8_MMA(1, 1, At, B1, false); PG8_BAR; PG8_SCHED; } while (0)
        if constexpr (F8 || I8) { int t = 0; PG8_ITER(true);
          for (t = 2; t < nt; t += 2) PG8_ITER(false); }
        else { for (int t = 0; t < nt; t += 2) PG8_ITER(false); }
#undef PG8_ITER
        int tz2 = tid; asm volatile("" : "+v"(tz2));
        const int lane2 = tz2 & 63, fr2 = lane2 & 15, fq2 = lane2 >> 4;
        typename EpiT::Pre pre; E.prefetch(pre, (const LAS float*)(lds + RSL_OFF), wr, fr2);
        if constexpr (ALIGN_EPI) { if (wr == 0) PG8_BAR; }
        if constexpr (F8 || I8) asm volatile("s_nop 15\n\ts_nop 15" ::: "memory");
        E(acc, cur, wr, wc, fr2, fq2, pre); S.done(cur);
        if (!has_next) break;
        PG8_ZERO();
        cur = nxt; cA = nA; cB = nB; ++ui;
        if constexpr (ALIGN_EPI) { if (wr == 1) PG8_BAR; }
    }
    PG8_WAIT_V(0);
    if constexpr (!ALIGN_EPI) { if (wr == 0) PG8_BAR; }
    PG8_BAR;
#undef PG8_SA
#undef PG8_SB
#undef PG8_STAGE
#undef PG8_LDA
#undef PG8_LDB
#undef PG8_MMA
#undef PG8_WAIT_V
#undef PG8_WAIT_L
#undef PG8_BAR
#undef PG8_SCHED
}
}

#define XB_TMO      128
#define XB_XCNT(j)  (256  + 64 * (j))
#define XB_XSUB(j)  (1280 + 64 * (j))
#define XB_XGEN(j)  (2304 + 64 * (j))
#define XB_TOP      3328
#define XB_TOPGEN   3392
#define XCD_BAR_WORDS 3456
#define XB_SPIN_CAP (1u << 18)
__device__ __forceinline__ unsigned xb_ld(unsigned* p)              { return __hip_atomic_load(p, __ATOMIC_RELAXED, __HIP_MEMORY_SCOPE_AGENT); }
__device__ __forceinline__ unsigned xb_add(unsigned* p, unsigned v) { return __hip_atomic_fetch_add(p, v, __ATOMIC_RELAXED, __HIP_MEMORY_SCOPE_AGENT); }
__device__ __forceinline__ unsigned xb_xcc_id() { return (unsigned)__builtin_amdgcn_s_getreg((3 << 11) | 20) & 0xFu; }
#define XB_SPIN(cond, bar) do { unsigned _sp = 0; while (cond) { __builtin_amdgcn_s_sleep(1); \
    if ((++_sp & 255u) == 0u) { if (xb_ld(&(bar)[XB_TMO])) break; if (_sp > XB_SPIN_CAP) { atomicAdd(&(bar)[XB_TMO], 1u); break; } } } } while (0)
struct XcdBarrier { unsigned* bar; unsigned x; volatile LAS unsigned* st; };
__device__ __forceinline__ XcdBarrier xcd_barrier_post(unsigned* bar, volatile LAS unsigned* st, const int tid) {
    XcdBarrier b; b.bar = bar; b.x = xb_xcc_id(); b.st = st;
    if (tid == 0) (void)xb_add(&bar[XB_XCNT(b.x)], 1u);
    return b;
}
__device__ __forceinline__ void xcd_barrier_complete(unsigned* bar, unsigned x, unsigned& nloc, unsigned& nx) {
    const unsigned G = gridDim.x * gridDim.y * gridDim.z;
    unsigned sum, cnt, mine, sp = 0u;
    for (;;) {
        sum = 0u; cnt = 0u; mine = 0u;
#pragma unroll
        for (unsigned j = 0; j < 16; ++j) { const unsigned c = xb_ld(&bar[XB_XCNT(j)]); sum += c; cnt += (c > 0u) ? 1u : 0u; mine = (j == x) ? c : mine; }
        if (sum == G) break;
        __builtin_amdgcn_s_sleep(1);
        if ((++sp & 255u) == 0u) { if (xb_ld(&bar[XB_TMO])) break; if (sp > XB_SPIN_CAP) { atomicAdd(&bar[XB_TMO], 1u); break; } }
    }
    nloc = mine > 0u ? mine : 1u; nx = cnt > 0u ? cnt : 1u;
}
__device__ __forceinline__ void xcd_barrier(const XcdBarrier& b, const int tid) {
    asm volatile("s_waitcnt vmcnt(0)" ::: "memory");
    __syncthreads();
    if (tid == 0) {
        unsigned* bar = b.bar;
        __builtin_amdgcn_s_waitcnt(0);
        unsigned nloc = b.st[0], nx = b.st[1];
        if (nloc == 0u) { xcd_barrier_complete(bar, b.x, nloc, nx); b.st[0] = nloc; b.st[1] = nx; }
        const unsigned old = xb_add(&bar[XB_XSUB(b.x)], 1u);
        const unsigned gen = old / nloc;
        if (old + 1u == (gen + 1u) * nloc) {
            __builtin_amdgcn_fence(__ATOMIC_RELEASE, "agent");
            asm volatile("s_waitcnt vmcnt(0)" ::: "memory");
            const unsigned og = xb_add(&bar[XB_TOP], 1u);
            const unsigned tg = og / nx;
            if (og + 1u == (tg + 1u) * nx) xb_add(&bar[XB_TOPGEN], 1u);
            else XB_SPIN(xb_ld(&bar[XB_TOPGEN]) == tg, bar);
            __builtin_amdgcn_fence(__ATOMIC_ACQUIRE, "agent");
            xb_add(&bar[XB_XGEN(b.x)], 1u);
            asm volatile("s_waitcnt vmcnt(0)" ::: "memory");
        } else {
            XB_SPIN(xb_ld(&bar[XB_XGEN(b.x)]) == gen, bar);
            __builtin_amdgcn_fence(__ATOMIC_ACQUIRE, "agent");
            asm volatile("s_waitcnt vmcnt(0)" ::: "memory");
        }
    }
    __syncthreads();
}

struct Args {
    const float* in[21]; float* out; unsigned char* ws; int ph_lo, ph_hi;
};
struct Frame {
    LAS unsigned char* lds;
    int wave, vcu, G;
};
__device__ __forceinline__ int frame_tid(const Frame& F) { unsigned seed = 0u; asm volatile("" : "+s"(seed));
    return F.wave * 64 + (int)__builtin_amdgcn_mbcnt_hi(~0u, __builtin_amdgcn_mbcnt_lo(~0u, seed)); }

__device__ __forceinline__ void transpose_item(const float* W, int K, int N, int k0, int n0, int nvalid, bf16_t* WT, size_t drow0, LAS float* scr, int lane, const float* gain) {
    const int nl = lane & 31;
    float tv[32];
#pragma unroll
    for (int i = 0; i < 32; ++i) { const int kk = 2 * i + (lane >> 5); tv[i] = (nl < nvalid) ? __builtin_nontemporal_load(W + (size_t)(k0 + kk) * N + n0 + nl) : 0.f; }
#pragma unroll
    for (int i = 0; i < 32; ++i) { const int kk = 2 * i + (lane >> 5); scr[kk * 33 + nl] = tv[i]; }
    LDS_WAIT(); asm volatile("" ::: "memory");
    const int c = lane & 7;
    f32x4 g0 = {1.f, 1.f, 1.f, 1.f}, g1 = {1.f, 1.f, 1.f, 1.f};
    if (gain) { g0 = *(const f32x4*)(gain + k0 + 8 * c); g1 = *(const f32x4*)(gain + k0 + 8 * c + 4); }
#pragma unroll
    for (int j = 0; j < 4; ++j) { const int n = (lane >> 3) + 8 * j; const LAS float* s = scr + (8 * c) * 33 + n;
        u32x4 o; o.x = cvt_pk_bf16(s[0 * 33] * g0[0], s[1 * 33] * g0[1]); o.y = cvt_pk_bf16(s[2 * 33] * g0[2], s[3 * 33] * g0[3]); o.z = cvt_pk_bf16(s[4 * 33] * g1[0], s[5 * 33] * g1[1]); o.w = cvt_pk_bf16(s[6 * 33] * g1[2], s[7 * 33] * g1[3]);
        *(u32x4*)(WT + (drow0 + n) * K + k0 + 8 * c) = o; }
    LDS_WAIT(); asm volatile("" ::: "memory");
}
__device__ __forceinline__ u32x2 pack8_b8(const float (&v)[8], bool i8) {
    if (i8) {
        unsigned w0 = 0u, w1 = 0u;
#pragma unroll
        for (int q = 0; q < 4; ++q) { w0 = __builtin_amdgcn_cvt_pk_u8_f32(fminf(fmaxf(v[q], -127.f), 127.f) + 128.f, q, w0); w1 = __builtin_amdgcn_cvt_pk_u8_f32(fminf(fmaxf(v[4 + q], -127.f), 127.f) + 128.f, q, w1); }
        return (u32x2){w0 ^ 0x80808080u, w1 ^ 0x80808080u};
    }
    float c[8];
#pragma unroll
    for (int q = 0; q < 8; ++q) c[q] = fminf(fmaxf(v[q], -448.f), 448.f);
    int w0 = 0, w1 = 0;
    w0 = __builtin_amdgcn_cvt_pk_fp8_f32(c[0], c[1], w0, false); w0 = __builtin_amdgcn_cvt_pk_fp8_f32(c[2], c[3], w0, true);
    w1 = __builtin_amdgcn_cvt_pk_fp8_f32(c[4], c[5], w1, false); w1 = __builtin_amdgcn_cvt_pk_fp8_f32(c[6], c[7], w1, true);
    return (u32x2){(unsigned)w0, (unsigned)w1};
}
__device__ __forceinline__ void transpose_item_b8(const float* W, int K, int N, int k0, int n0, int nvalid, unsigned char* WT8, size_t drow0, LAS float* scr, int lane, const float* gain, float scale, bool i8) {
    const int nl = lane & 31;
    float tv[32];
#pragma unroll
    for (int i = 0; i < 32; ++i) { const int kk = 2 * i + (lane >> 5); tv[i] = (nl < nvalid) ? __builtin_nontemporal_load(W + (size_t)(k0 + kk) * N + n0 + nl) : 0.f; }
#pragma unroll
    for (int i = 0; i < 32; ++i) { const int kk = 2 * i + (lane >> 5); scr[kk * 33 + nl] = tv[i]; }
    LDS_WAIT(); asm volatile("" ::: "memory");
    const int c = lane & 7;
    f32x4 g0 = {scale, scale, scale, scale}, g1 = g0;
    if (gain) { g0 = *(const f32x4*)(gain + k0 + 8 * c) * scale; g1 = *(const f32x4*)(gain + k0 + 8 * c + 4) * scale; }
#pragma unroll
    for (int j = 0; j < 4; ++j) { const int n = (lane >> 3) + 8 * j; const LAS float* s = scr + (8 * c) * 33 + n;
        float v[8];
#pragma unroll
        for (int q = 0; q < 8; ++q) v[q] = s[q * 33] * (q < 4 ? g0[q & 3] : g1[q & 3]);
        *(u32x2*)(WT8 + (drow0 + n) * K + k0 + 8 * c) = pack8_b8(v, i8); }
    LDS_WAIT(); asm volatile("" ::: "memory");
}
__device__ __forceinline__ void conv_swiglu_b8(const float* W, unsigned char* WT8, int item, LAS float* scr, int lane, const float* gain, float scale, bool i8) {
    const int nblk = NFF / 32, kb = item / nblk, nb = item % nblk, n0 = 32 * nb;
    const int isb = n0 >= FF, n1 = isb ? n0 - FF : n0;
    const size_t drow = (size_t)(n1 >> 7) * 256 + (isb ? 128 : 0) + (n1 & 127);
    transpose_item_b8(W, DM, NFF, 64 * kb, n0, 32, WT8, drow, scr, lane, gain, scale, i8);
}
__device__ __forceinline__ void conv_plain_b8(const float* W, int K, int N, unsigned char* WT8, size_t drow_off, int item, LAS float* scr, int lane, const float* gain, float scale, bool i8) {
    const int nblk = (N + 31) / 32, kb = item / nblk, nb = item % nblk, n0 = 32 * nb;
    const int nv = (N - n0) < 32 ? (N - n0) : 32;
    transpose_item_b8(W, K, N, 64 * kb, n0, nv, WT8, drow_off + n0, scr, lane, gain, scale, i8);
}
__device__ __forceinline__ void conv_plain(const float* W, int K, int N, bf16_t* WT, size_t drow_off, int item, LAS float* scr, int lane, const float* gain) {
    const int nblk = (N + 31) / 32, kb = item / nblk, nb = item % nblk, n0 = 32 * nb;
    const int nv = (N - n0) < 32 ? (N - n0) : 32;
    transpose_item(W, K, N, 64 * kb, n0, nv, WT, drow_off + n0, scr, lane, gain);
}
__device__ __forceinline__ void conv_swiglu(const float* W, bf16_t* WT, int item, LAS float* scr, int lane, const float* gain) {
    const int nblk = NFF / 32, kb = item / nblk, nb = item % nblk, n0 = 32 * nb;
    const int isb = n0 >= FF, n1 = isb ? n0 - FF : n0;
    const size_t drow = (size_t)(n1 >> 7) * 256 + (isb ? 128 : 0) + (n1 & 127);
    transpose_item(W, DM, NFF, 64 * kb, n0, 32, WT, drow, scr, lane, gain);
}

constexpr int CV_S1 = (DM / 64) * (NFF / 32) + (FF / 64) * (DM / 32), CV_S2 = 2 * CV_S1,
              CV_END = CV_S2 + (DM / 64) * ((INCOLS + 31) / 32) + (DM / 64) * (2 * DM / 32) + 2 * (SGW / 64) * (DM / 32) + (DM / 64) * (DM / 32) + ((ZG - 6240) * DM * 2) / 1024 + 8 * 128 * 128 / 512;
struct LayerW {
    const float *f1i, *f1o, *f2i, *f2o, *win, *wg, *wa, *wb, *wo, *wss, *g_f1, *g_f2, *g_mix; bool f8_1, f8_2, q8_1, q8_2, q8_m;
};
__device__ __forceinline__ void conv_phase(const Frame& F, const LayerW& L, unsigned char* ws, const int tz, int widx, int nworkers, int it_lo, int it_hi) {
    const int lane_ = tz & 63;
    LAS float* scr = (LAS float*)(F.lds + F.wave * 8704);
    const int gw = widx * NWAVES + F.wave, NGW = nworkers * NWAVES;
    constexpr int I_FI = (DM / 64) * (NFF / 32), I_FO = (FF / 64) * (DM / 32), I_WIN = (DM / 64) * ((INCOLS + 31) / 32), I_WG = (DM / 64) * (2 * DM / 32),
                  I_WA = (SGW / 64) * (DM / 32), I_WO = (DM / 64) * (DM / 32), I_ZERO = ((ZG - 6240) * DM * 2) / 1024, I_WSS = 8 * 128 * 128 / 512;
    constexpr int NITEMS = 2 * I_FI + 2 * I_FO + I_WIN + I_WG + 2 * I_WA + I_WO + I_ZERO + I_WSS;
    bf16_t* wf1i = (bf16_t*)(ws + WS_WF1I); bf16_t* wf1o = (bf16_t*)(ws + WS_WF1O); bf16_t* wf2i = (bf16_t*)(ws + WS_WF2I); bf16_t* wf2o = (bf16_t*)(ws + WS_WF2O);
    bf16_t* wmix = (bf16_t*)(ws + WS_WMIX); bf16_t* wa = (bf16_t*)(ws + WS_WA); bf16_t* wb = (bf16_t*)(ws + WS_WB); bf16_t* wo = (bf16_t*)(ws + WS_WO);
    (void)NITEMS;
    for (int it = it_lo + gw; it < it_hi; it += NGW) {
        int r = it;
        if (r < I_FI) { if (L.q8_1) conv_swiglu_b8(L.f1i, (unsigned char*)wf1i, r, scr, lane_, L.g_f1, I8_SWQ, true); else conv_swiglu(L.f1i, wf1i, r, scr, lane_, L.g_f1); continue; } r -= I_FI;
        if (r < I_FO) { if (L.f8_1) conv_plain_b8(L.f1o, FF, DM, (unsigned char*)wf1o, 0, r, scr, lane_, nullptr, F8_SW, false); else conv_plain(L.f1o, FF, DM, wf1o, 0, r, scr, lane_, nullptr); continue; } r -= I_FO;
        if (r < I_FI) { if (L.q8_2) conv_swiglu_b8(L.f2i, (unsigned char*)wf2i, r, scr, lane_, L.g_f2, I8_SWQ, true); else conv_swiglu(L.f2i, wf2i, r, scr, lane_, L.g_f2); continue; } r -= I_FI;
        if (r < I_FO) { if (L.f8_2) conv_plain_b8(L.f2o, FF, DM, (unsigned char*)wf2o, 0, r, scr, lane_, nullptr, F8_SW, false); else conv_plain(L.f2o, FF, DM, wf2o, 0, r, scr, lane_, nullptr); continue; } r -= I_FO;
        if (r < I_WIN) { if (L.q8_m) conv_plain_b8(L.win, DM, INCOLS, (unsigned char*)wmix, 0, r, scr, lane_, L.g_mix, I8_SWQ, true); else conv_plain(L.win, DM, INCOLS, wmix, 0, r, scr, lane_, L.g_mix); continue; } r -= I_WIN;
        if (r < I_WG) { if (L.q8_m) conv_plain_b8(L.wg, DM, 2 * DM, (unsigned char*)wmix, ZG, r, scr, lane_, L.g_mix, I8_SWQ, true); else conv_plain(L.wg, DM, 2 * DM, wmix, ZG, r, scr, lane_, L.g_mix); continue; } r -= I_WG;
        if (r < I_WA) { conv_plain(L.wa, SGW, DM, wa, 0, r, scr, lane_, nullptr); continue; } r -= I_WA;
        if (r < I_WA) { conv_plain(L.wb, SGW, DM, wb, 0, r, scr, lane_, nullptr); continue; } r -= I_WA;
        if (r < I_WO) { conv_plain(L.wo, DM, DM, wo, 0, r, scr, lane_, nullptr); continue; } r -= I_WO;
        if (r < I_ZERO) { unsigned z0 = 0u; asm volatile("" : "+v"(z0)); const size_t esz = L.q8_m ? 1 : 2;
            u32x4* z = (u32x4*)((unsigned char*)wmix + (size_t)6240 * DM * esz + ((size_t)r * 1024) % ((size_t)160 * DM * esz)) + lane_; *z = (u32x4){z0, z0, z0, z0}; continue; } r -= I_ZERO;
        {
            const int e0 = r * 512 + lane_ * 8, t = (e0 >> 7) & 127, s0 = e0 & 127;
            const f32x4 a = *(const f32x4*)(L.wss + e0), c = *(const f32x4*)(L.wss + e0 + 4);
            float v[8] = {a[0], a[1], a[2], a[3], c[0], c[1], c[2], c[3]};
#pragma unroll
            for (int j = 0; j < 8; ++j) v[j] = (s0 + j <= t) ? v[j] : 0.f;
            u32x4 o; o.x = cvt_pk_bf16(v[0], v[1]); o.y = cvt_pk_bf16(v[2], v[3]); o.z = cvt_pk_bf16(v[4], v[5]); o.w = cvt_pk_bf16(v[6], v[7]);
            *(u32x4*)((bf16_t*)(ws + WS_WSB) + e0) = o;
        }
    }
}

__device__ __forceinline__ void thin_phase(const Frame& F, const float* x_in, bf16_t* xb, const bf16_t* f, const float* gpost, float scale, float* rs, float* xf, unsigned char* xq, const int tz) {
    const int lane_ = tz & 63;
    const int gw = F.vcu * NWAVES + F.wave, NGW = F.G * NWAVES;
    f32x4 v[8]; u32x2 xw[8], nxw[8], fw[8], nfw[8]; f32x4 nv[8];
    int m = gw;
    if (m < MT) {
        if (x_in) { const f32x4* xr = (const f32x4*)(x_in + (size_t)m * DM) + lane_;
#pragma unroll
            for (int j = 0; j < 8; ++j) v[j] = __builtin_nontemporal_load(xr + 64 * j); }
        else { const u32x2* xr = (const u32x2*)(xb + (size_t)m * DM) + lane_;
#pragma unroll
            for (int j = 0; j < 8; ++j) xw[j] = __builtin_nontemporal_load(xr + 64 * j); }
        if (f) { const u32x2* fr = (const u32x2*)(f + (size_t)m * DM) + lane_;
#pragma unroll
            for (int j = 0; j < 8; ++j) fw[j] = __builtin_nontemporal_load(fr + 64 * j); }
    }
    f32x4 gq[8];
    if (f) { const f32x4* gp = (const f32x4*)gpost + lane_;
#pragma unroll
        for (int j = 0; j < 8; ++j) gq[j] = gp[64 * j]; }
    for (; m < MT; m += NGW) {
        const int mn_ = m + NGW;
        if (mn_ < MT) {
            if (x_in) { const f32x4* xr = (const f32x4*)(x_in + (size_t)mn_ * DM) + lane_;
#pragma unroll
                for (int j = 0; j < 8; ++j) nv[j] = __builtin_nontemporal_load(xr + 64 * j); }
            else { const u32x2* xr = (const u32x2*)(xb + (size_t)mn_ * DM) + lane_;
#pragma unroll
                for (int j = 0; j < 8; ++j) nxw[j] = __builtin_nontemporal_load(xr + 64 * j); }
            if (f) { const u32x2* fr = (const u32x2*)(f + (size_t)mn_ * DM) + lane_;
#pragma unroll
                for (int j = 0; j < 8; ++j) nfw[j] = __builtin_nontemporal_load(fr + 64 * j); }
        }
        if (!x_in) {
#pragma unroll
            for (int j = 0; j < 8; ++j) v[j] = (f32x4){bf_lo(xw[j].x), bf_hi(xw[j].x), bf_lo(xw[j].y), bf_hi(xw[j].y)};
        }
        if (f) {
            f32x4 fv[8]; float s = 0.f;
#pragma unroll
            for (int j = 0; j < 8; ++j) { const u32x2 w = fw[j]; fv[j] = (f32x4){bf_lo(w.x), bf_hi(w.x), bf_lo(w.y), bf_hi(w.y)}; s += (fv[j][0] * fv[j][0] + fv[j][1] * fv[j][1]) + (fv[j][2] * fv[j][2] + fv[j][3] * fv[j][3]); }
            const float r = scale * __builtin_amdgcn_rsqf(wave_sum(s, lane_) * (1.f / DM) + NORM_EPS);
#pragma unroll
            for (int j = 0; j < 8; ++j) v[j] = v[j] + fv[j] * gq[j] * r;
        }
        if (xf) {
            f32x4* xo = (f32x4*)(xf + (size_t)m * DM) + lane_;
#pragma unroll
            for (int j = 0; j < 8; ++j) __builtin_nontemporal_store(v[j], xo + 64 * j);
        } else {
            u32x2* xo = (u32x2*)(xb + (size_t)m * DM) + lane_;
            float s = 0.f;
#pragma unroll
            for (int j = 0; j < 8; ++j) { u32x2 w; w.x = cvt_pk_bf16(v[j][0], v[j][1]); w.y = cvt_pk_bf16(v[j][2], v[j][3]); __builtin_nontemporal_store(w, xo + 64 * j);
                s += (v[j][0] * v[j][0] + v[j][1] * v[j][1]) + (v[j][2] * v[j][2] + v[j][3] * v[j][3]); }
            const float r = __builtin_amdgcn_rsqf(wave_sum(s, lane_) * (1.f / DM) + NORM_EPS);
            if (lane_ == 0) rs[m] = r;
            if (xq) {
                float am = 0.f;
#pragma unroll
                for (int j = 0; j < 8; ++j) am = fmaxf(fmaxf(am, fmaxf(fabsf(v[j][0]), fabsf(v[j][1]))), fmaxf(fabsf(v[j][2]), fabsf(v[j][3])));
                am = wave_max(am);
                am = fmaxf(am, 1e-20f);
                const float qs = 127.f / am;
                unsigned* xqo = (unsigned*)(xq + (size_t)m * DM) + lane_;
#pragma unroll
                for (int j = 0; j < 8; ++j) { unsigned w8 = 0u;
#pragma unroll
                    for (int e = 0; e < 4; ++e) w8 = __builtin_amdgcn_cvt_pk_u8_f32(v[j][e] * qs + 128.f, e, w8);
                    xqo[64 * j] = w8 ^ 0x80808080u; }
                if (lane_ == 0) rs[MT + m] = r * am * (1.f / 127.f);
            }
        }
#pragma unroll
        for (int j = 0; j < 8; ++j) { v[j] = nv[j]; xw[j] = nxw[j]; fw[j] = nfw[j]; }
    }
}

constexpr int IDX_BUF = 256 * 128;
__device__ __forceinline__ void indexer_unit(LAS unsigned char* lds, const bf16_t* Z, unsigned* mask, int b, int tb, int wave, int tid) {
    asm volatile("" : "+v"(tid));
    const int lane = tid & 63, hi = lane >> 5, r32 = lane & 31;
    const int t0 = tb + 2 * wave, tq = t0 + hi;
    const int aq = t0 + ((r32 >> 2) & 1), ah = (r32 >> 3) * 4 + (r32 & 3);
    const bf16_t* ap = Z + (size_t)(b * SEQ + aq) * LDZ + ZQI + ah * 64 + hi * 8;
    bf16x8 af[4];
#pragma unroll
    for (int ks = 0; ks < 4; ++ks) af[ks] = *(const bf16x8*)(ap + 16 * ks);
    float wv[16];
    { const u32x4* wp = (const u32x4*)(Z + (size_t)(b * SEQ + tq) * LDZ + ZWI); const u32x4 w0 = wp[0], w1 = wp[1];
      const float sc = 0.125f * 0.25f;
      wv[0] = bf_lo(w0.x) * sc; wv[1] = bf_hi(w0.x) * sc; wv[2] = bf_lo(w0.y) * sc; wv[3] = bf_hi(w0.y) * sc; wv[4] = bf_lo(w0.z) * sc; wv[5] = bf_hi(w0.z) * sc; wv[6] = bf_lo(w0.w) * sc; wv[7] = bf_hi(w0.w) * sc;
      wv[8] = bf_lo(w1.x) * sc; wv[9] = bf_hi(w1.x) * sc; wv[10] = bf_lo(w1.y) * sc; wv[11] = bf_hi(w1.y) * sc; wv[12] = bf_lo(w1.z) * sc; wv[13] = bf_hi(w1.z) * sc; wv[14] = bf_lo(w1.w) * sc; wv[15] = bf_hi(w1.w) * sc; }
    const int nkt = (t0 + 1) / 32 + 1;
    const int nch = (tb + 15) / 256 + 1;
    const int srow = lane >> 3, spiece = (lane & 7) ^ (srow >> 1);
    const bf16_t* gkr = Z + (size_t)(b * SEQ + 32 * wave + srow) * LDZ + ZKI;
    const bf16_t* gk = gkr + spiece * 8; const bf16_t* gk4 = gkr + (spiece ^ 4) * 8;
    const unsigned rd0 = (unsigned)(r32 * 128), rsw = (unsigned)((r32 >> 1) & 7);
    unsigned rdo[4];
#pragma unroll
    for (int ks = 0; ks < 4; ++ks) rdo[ks] = rd0 + ((((unsigned)hi + 2u * ks) ^ rsw) << 4);
    __syncthreads();
#pragma unroll
    for (int i = 0; i < 4; ++i)
        __builtin_amdgcn_global_load_lds((const unsigned*)(((i & 1) ? gk4 : gk) + (size_t)(8 * i) * LDZ), (LAS unsigned*)(lds + wave * 4096 + i * 1024), 16, 0, 0);
    unsigned key[128];
#pragma unroll
    for (int c = 0; c < 16; ++c) {
#pragma unroll
        for (int k = 0; k < 8; ++k) key[c * 8 + k] = 0u;
        if (c < nch) {
            asm volatile("s_waitcnt vmcnt(0)" ::: "memory");
            __syncthreads();
            if (c + 1 < nch) {
#pragma unroll
                for (int i = 0; i < 4; ++i)
                    __builtin_amdgcn_global_load_lds((const unsigned*)(((i & 1) ? gk4 : gk) + (size_t)(256 * (c + 1) + 8 * i) * LDZ), (LAS unsigned*)(lds + ((c + 1) & 1) * IDX_BUF + wave * 4096 + i * 1024), 16, 0, 0);
            }
#pragma unroll
            for (int k = 0; k < 8; k += 2) {
                const int kt = c * 8 + k;
                const LAS unsigned char* bp = lds + (c & 1) * IDX_BUF + k * 4096;
                bf16x8 bfa[4], bfb[4];
#pragma unroll
                for (int ks = 0; ks < 4; ++ks) { bfa[ks] = *(const LAS bf16x8*)(bp + rdo[ks]); bfb[ks] = *(const LAS bf16x8*)(bp + 4096 + rdo[ks]); }
                f32x16 acca = {}, accb = {};
#pragma unroll
                for (int ks = 0; ks < 4; ++ks) { acca = __builtin_amdgcn_mfma_f32_32x32x16_bf16(af[ks], bfa[ks], acca, 0, 0, 0); accb = __builtin_amdgcn_mfma_f32_32x32x16_bf16(af[ks], bfb[ks], accb, 0, 0, 0); }
                {
                    f32x2 s2 = {0.f, 0.f};
#pragma unroll
                    for (int r = 0; r < 16; r += 2) { int r0 = __float_as_int(acca[r]), r1 = __float_as_int(acca[r + 1]); r0 = r0 > 0 ? r0 : 0; r1 = r1 > 0 ? r1 : 0;
                        s2 = __builtin_elementwise_fma((f32x2){__int_as_float(r0), __int_as_float(r1)}, (f32x2){wv[r], wv[r + 1]}, s2); }
                    float s = s2[0] + s2[1];
                    asm volatile("" : "+v"(s));
                    const unsigned u = __float_as_uint(s);
                    const unsigned kk = u ^ ((unsigned)((int)u >> 31) | 0x80000000u);
                    key[kt] = (32 * kt + r32 <= tq) ? kk : 0u;
                }
                {
                    f32x2 s2 = {0.f, 0.f};
#pragma unroll
                    for (int r = 0; r < 16; r += 2) { int r0 = __float_as_int(accb[r]), r1 = __float_as_int(accb[r + 1]); r0 = r0 > 0 ? r0 : 0; r1 = r1 > 0 ? r1 : 0;
                        s2 = __builtin_elementwise_fma((f32x2){__int_as_float(r0), __int_as_float(r1)}, (f32x2){wv[r], wv[r + 1]}, s2); }
                    float s = s2[0] + s2[1];
                    asm volatile("" : "+v"(s));
                    const unsigned u = __float_as_uint(s);
                    const unsigned kk = u ^ ((unsigned)((int)u >> 31) | 0x80000000u);
                    key[kt + 1] = (32 * (kt + 1) + r32 <= tq) ? kk : 0u;
                }
                __builtin_amdgcn_sched_barrier(0);
            }
        }
    }
    unsigned T = 0u;
    if (t0 + 1 >= TOPK) {
        bool done = tq < TOPK;
        for (int bit = 31; bit >= 0; --bit) {
            const unsigned cand = T | (1u << bit);
            unsigned c = 0u;
#pragma unroll
            for (int k8 = 0; k8 < 16; ++k8) {
                if (k8 * 8 < nkt) {
                    asm volatile("v_cmp_ge_u32_e64 s[20:21], %1, %9\n\tv_cmp_ge_u32_e64 s[22:23], %2, %9\n\tv_cmp_ge_u32_e64 s[24:25], %3, %9\n\tv_cmp_ge_u32_e64 s[26:27], %4, %9\n\t"
                                 "v_addc_co_u32_e64 %0, s[28:29], %0, 0, s[20:21]\n\tv_addc_co_u32_e64 %0, s[28:29], %0, 0, s[22:23]\n\tv_addc_co_u32_e64 %0, s[28:29], %0, 0, s[24:25]\n\tv_addc_co_u32_e64 %0, s[28:29], %0, 0, s[26:27]\n\t"
                                 "v_cmp_ge_u32_e64 s[20:21], %5, %9\n\tv_cmp_ge_u32_e64 s[22:23], %6, %9\n\tv_cmp_ge_u32_e64 s[24:25], %7, %9\n\tv_cmp_ge_u32_e64 s[26:27], %8, %9\n\t"
                                 "v_addc_co_u32_e64 %0, s[28:29], %0, 0, s[20:21]\n\tv_addc_co_u32_e64 %0, s[28:29], %0, 0, s[22:23]\n\tv_addc_co_u32_e64 %0, s[28:29], %0, 0, s[24:25]\n\tv_addc_co_u32_e64 %0, s[28:29], %0, 0, s[26:27]"
                                 : "+v"(c)
                                 : "v"(key[k8 * 8 + 0]), "v"(key[k8 * 8 + 1]), "v"(key[k8 * 8 + 2]), "v"(key[k8 * 8 + 3]), "v"(key[k8 * 8 + 4]), "v"(key[k8 * 8 + 5]), "v"(key[k8 * 8 + 6]), "v"(key[k8 * 8 + 7]), "v"(cand)
                                 : "s20", "s21", "s22", "s23", "s24", "s25", "s26", "s27", "s28", "s29");
                }
            }
            asm volatile("s_nop 1" : "+v"(c));
            c += (unsigned)__builtin_amdgcn_update_dpp(0, (int)c, 0xB1, 0xF, 0xF, true);  c += (unsigned)__builtin_amdgcn_update_dpp(0, (int)c, 0x4E, 0xF, 0xF, true);
            c += (unsigned)__builtin_amdgcn_update_dpp(0, (int)c, 0x141, 0xF, 0xF, true); c += (unsigned)__builtin_amdgcn_update_dpp(0, (int)c, 0x140, 0xF, 0xF, true);
            { auto rr = __builtin_amdgcn_permlane16_swap(c, c, false, false); c = rr[0] + rr[1]; }
            if (!done && c >= (unsigned)TOPK) T = cand;
            done = done || (c == (unsigned)TOPK);
            if (__all(done)) break;
        }
        if (tq < TOPK) T = 0u;
    }
    if (T == 0u) T = 1u;
    const int nw = ((t0 >> 8) + 1) * 8;
    unsigned a0 = 0u, a1 = 0u, b0 = 0u, b1 = 0u;
#define IDX_DEP(j) { const unsigned long long balA = __ballot(key[(j)] >= T), balB = __ballot(key[(j) + 64] >= T); \
        const unsigned lA = (unsigned)balA, hA = (unsigned)(balA >> 32), lB = (unsigned)balB, hB = (unsigned)(balB >> 32); \
        asm volatile("s_nop 3\n\tv_writelane_b32 %0, %4, %8\n\tv_writelane_b32 %1, %5, %8\n\tv_writelane_b32 %2, %6, %8\n\tv_writelane_b32 %3, %7, %8" \
                     : "+v"(a0), "+v"(a1), "+v"(b0), "+v"(b1) : "s"(lA), "s"(hA), "s"(lB), "s"(hB), "n"(j)); }
#define IDX_DEP4(j) IDX_DEP(j) IDX_DEP((j) + 1) IDX_DEP((j) + 2) IDX_DEP((j) + 3)
#define IDX_DEP16(j) IDX_DEP4(j) IDX_DEP4((j) + 4) IDX_DEP4((j) + 8) IDX_DEP4((j) + 12)
    IDX_DEP16(0) IDX_DEP16(16) IDX_DEP16(32) IDX_DEP16(48)
#undef IDX_DEP16
#undef IDX_DEP4
#undef IDX_DEP
    unsigned* m0 = mask + (size_t)(b * SEQ + t0) * 128; unsigned* m1 = m0 + 128;
    if (lane < nw) { m0[lane] = a0; m1[lane] = a1; }
    if (64 + lane < nw) { m0[64 + lane] = b0; m1[64 + lane] = b1; }
}

__device__ __forceinline__ void sgu_unit(const Frame& F, const bf16_t* Z, bf16_t* YA, const float* lng, const float* lnb, const bf16_t* wsb, const float* bs_, int b, int n, int half, const int tz) {
    LAS float* part = (LAS float*)F.lds;
    LAS float* stat = (LAS float*)(F.lds + 8192);
    LAS bf16_t* VT = (LAS bf16_t*)(F.lds + 8192 + 1024 + F.wave * 8704);
    LAS float* CT = (LAS float*)(F.lds + 8192 + 1024 + 8 * 8704 + F.wave * 4352);
    const int w = F.wave, lane = tz & 63, tid_ = tz;
    const size_t R0 = (size_t)b * SEQ + (size_t)n * 128;
    __syncthreads();
    {
        const bf16_t* Vs = Z + R0 * LDZ + ZV + 128 * w;
        const int ch = lane & 15, rq = lane >> 4;
#pragma unroll 8
        for (int i = 0; i < 32; ++i) {
            const int row = rq + 4 * i;
            const u32x4 x = *(const u32x4*)(Vs + (size_t)row * LDZ + 8 * ch);
            const float x0 = bf_lo(x.x), x1 = bf_hi(x.x), x2 = bf_lo(x.y), x3 = bf_hi(x.y), x4 = bf_lo(x.z), x5 = bf_hi(x.z), x6 = bf_lo(x.w), x7 = bf_hi(x.w);
            float s = ((x0 + x1) + (x2 + x3)) + ((x4 + x5) + (x6 + x7));
            float q = ((x0 * x0 + x1 * x1) + (x2 * x2 + x3 * x3)) + ((x4 * x4 + x5 * x5) + (x6 * x6 + x7 * x7));
#define DPPADD(v, ctl) v += __int_as_float(__builtin_amdgcn_update_dpp(0, __float_as_int(v), ctl, 0xF, 0xF, true))
            DPPADD(s, 0xB1); DPPADD(q, 0xB1); DPPADD(s, 0x4E); DPPADD(q, 0x4E); DPPADD(s, 0x141); DPPADD(q, 0x141); DPPADD(s, 0x140); DPPADD(q, 0x140);
#undef DPPADD
            if (ch == 0) { part[(row * 8 + w) * 2] = s; part[(row * 8 + w) * 2 + 1] = q; }
        }
    }
    __syncthreads();
    if (tid_ < 128) {
        float s = 0.f, q = 0.f;
#pragma unroll
        for (int k = 0; k < 8; ++k) { s += part[(tid_ * 8 + k) * 2]; q += part[(tid_ * 8 + k) * 2 + 1]; }
        const float mean = s * (1.f / SGW); const float var = fmaxf(q * (1.f / SGW) - mean * mean, 0.f);
        stat[tid_ * 2] = mean; stat[tid_ * 2 + 1] = __builtin_amdgcn_rsqf(var + LN_EPS);
    }
    __syncthreads();
    const int r32 = lane & 31, hi = lane >> 5;
    const int g = 4 * half + (w >> 1);
    const bf16_t* wsg = wsb + (size_t)g * 128 * 128;
    const bf16_t* Vg = Z + R0 * LDZ + ZV + 128 * g;
    const bf16_t* Ug = Z + R0 * LDZ + ZU + 128 * g;
    bf16_t* Yg = YA + R0 * SGW + 128 * g;
#pragma unroll 1
    for (int qq = 0; qq < 2; ++qq) {
        const int qtr = 2 * (w & 1) + qq;
        {
            const int ch = lane & 3, rq = lane >> 2;
            const int c0 = 128 * g + 32 * qtr + 8 * ch;
            const f32x4 g0 = *(const f32x4*)(lng + c0), g1 = *(const f32x4*)(lng + c0 + 4), b0 = *(const f32x4*)(lnb + c0), b1 = *(const f32x4*)(lnb + c0 + 4);
#pragma unroll
            for (int i = 0; i < 8; ++i) {
                const int s = rq + 16 * i;
                const u32x4 x4 = *(const u32x4*)(Vg + (size_t)s * LDZ + 32 * qtr + 8 * ch);
                const float mean = stat[s * 2], rstd = stat[s * 2 + 1];
                float x[8] = {bf_lo(x4.x), bf_hi(x4.x), bf_lo(x4.y), bf_hi(x4.y), bf_lo(x4.z), bf_hi(x4.z), bf_lo(x4.w), bf_hi(x4.w)};
#pragma unroll
                for (int j = 0; j < 8; ++j) { const float gg = j < 4 ? g0[j & 3] : g1[j & 3], bb = j < 4 ? b0[j & 3] : b1[j & 3];
                    const float y = (x[j] - mean) * rstd * gg + bb;
                    VT[(8 * ch + j) * 136 + s] = (bf16_t)(cvt_pk_bf16(y, 0.f) & 0xffffu); }
            }
        }
        LDS_WAIT(); asm volatile("" ::: "memory");
        bf16x8 bfr[8];
#pragma unroll
        for (int ks = 0; ks < 8; ++ks) bfr[ks] = *(const LAS bf16x8*)(VT + r32 * 136 + 16 * ks + 8 * hi);
#pragma unroll 1
        for (int mt = 0; mt < 4; ++mt) {
            f32x16 acc = {};
            const int t = 32 * mt + r32;
#pragma unroll
            for (int ks = 0; ks < 8; ++ks) {
                if (ks < 2 * mt + 2) {
                    const bf16x8 a = *(const bf16x8*)(wsg + (size_t)t * 128 + 16 * ks + 8 * hi);
                    acc = __builtin_amdgcn_mfma_f32_32x32x16_bf16(a, bfr[ks], acc, 0, 0, 0);
                }
            }
#pragma unroll
            for (int r = 0; r < 16; ++r) CT[((r & 3) + 8 * (r >> 2) + 4 * hi) * 34 + r32] = acc[r];
            LDS_WAIT(); asm volatile("" ::: "memory");
#pragma unroll
            for (int it = 0; it < 2; ++it) {
                const int tl = (lane >> 2) + 16 * it, cc = (lane & 3) * 8, tt = 32 * mt + tl;
                const float bias = bs_[g * 128 + tt];
                const u32x4 uu = *(const u32x4*)(Ug + (size_t)tt * LDZ + 32 * qtr + cc);
                const LAS float* cr = CT + tl * 34 + cc;
                u32x4 o;
                o.x = cvt_pk_bf16((cr[0] + bias) * bf_lo(uu.x), (cr[1] + bias) * bf_hi(uu.x)); o.y = cvt_pk_bf16((cr[2] + bias) * bf_lo(uu.y), (cr[3] + bias) * bf_hi(uu.y));
                o.z = cvt_pk_bf16((cr[4] + bias) * bf_lo(uu.z), (cr[5] + bias) * bf_hi(uu.z)); o.w = cvt_pk_bf16((cr[6] + bias) * bf_lo(uu.w), (cr[7] + bias) * bf_hi(uu.w));
                *(u32x4*)(Yg + (size_t)tt * SGW + 32 * qtr + cc) = o;
            }
            LDS_WAIT(); asm volatile("" ::: "memory");
        }
    }
}

namespace att {
constexpr int D = 128, KVBLK = 64, QBLK = 32, QB = 256;
constexpr int SHM_V = KVBLK * D * 2, SHM_K = KVBLK * D * 2;
constexpr float SCALE = 0.08838834764831845f;
constexpr float THR = 8.f;
constexpr int NBUF = 4;
constexpr int KRING = NBUF * SHM_V, WS_OFF = LDSCTL_OFF + 8192, TB_OFF = WS_OFF + NWAVES * 64 * 4, ATT_LDS = TB_OFF + 2048;
static_assert(ATT_LDS <= LDS_BYTES, "attention LDS map");
#define KSWZ(row, colB) ((row) * 256 + ((colB) ^ (((row) & 7) << 4)))
#define SBAR() __builtin_amdgcn_sched_barrier(0)
__device__ __forceinline__ int v_st(int k, int c) { const int kk = (k & ~0xC) | ((k & 4) << 1) | ((k & 8) >> 1); return ((kk >> 3) * 4 + (c >> 5)) * 512 + ((kk & 7) * 32 + (c & 31)) * 2; }
__device__ __forceinline__ int v_rd_base(int lane) { return ((lane & 3) << 3) | (((lane >> 2) & 3) << 6) | (((lane >> 4) & 1) << 5) | (((lane >> 5) & 1) << 8); }
constexpr int v_rd_off(int d0, int ks, int half) { return d0 * 512 + ks * 4096 + half * 2048; }
__device__ __forceinline__ int crow(int r, int hi) { return (r & 3) + 8 * (r >> 2) + 4 * hi; }
__device__ __forceinline__ void partialSM(f32x16& p0, f32x16& p1, float& m_reg, float l_reg, float& alpha) {
    float pmax = p0[0];
#pragma unroll
    for (int r = 1; r < 16; ++r) pmax = fmaxf(pmax, p0[r]);
#pragma unroll
    for (int r = 0; r < 16; ++r) pmax = fmaxf(pmax, p1[r]);
    { auto rr = __builtin_amdgcn_permlane32_swap(__float_as_uint(pmax), __float_as_uint(pmax), false, false);
      pmax = fmaxf(__uint_as_float(rr[0]), __uint_as_float(rr[1])); }
    constexpr float THRL = THR * 1.4426950408889634f;
    const bool fresh = (l_reg == 0.f) & (pmax < -THRL) & (pmax > -3.0e38f);
    if (__builtin_expect(!__any((pmax > THRL) | fresh), 1)) { alpha = 1.f; }
    else { const float d = fresh ? pmax : fmaxf(pmax, 0.f); alpha = fresh ? 1.f : __builtin_amdgcn_exp2f(-d); m_reg += d;
#pragma unroll
        for (int r = 0; r < 16; ++r) { p0[r] -= d; p1[r] -= d; } }
#pragma unroll
    for (int r = 0; r < 16; ++r) p0[r] = __builtin_amdgcn_exp2f(p0[r]);
}
__device__ __forceinline__ void finishSM(f32x16& p0, f32x16& p1, float alpha, float& l_reg, bf16x8& pa0, bf16x8& pa1, bf16x8& pa2, bf16x8& pa3) {
#pragma unroll
    for (int r = 0; r < 16; ++r) p1[r] = __builtin_amdgcn_exp2f(p1[r]);
    float ps = 0;
#pragma unroll
    for (int r = 0; r < 16; ++r) ps += p0[r];
#pragma unroll
    for (int r = 0; r < 16; ++r) ps += p1[r];
    { auto rr = __builtin_amdgcn_permlane32_swap(__float_as_uint(ps), __float_as_uint(ps), false, false);
      ps = __uint_as_float(rr[0]) + __uint_as_float(rr[1]); }
    l_reg = l_reg * alpha + ps;
#define PK4(P, B_, OUT) do { unsigned a0 = cvt_pk_bf16(P[B_+0], P[B_+1]), a1 = cvt_pk_bf16(P[B_+2], P[B_+3]);                          \
        unsigned b0 = cvt_pk_bf16(P[B_+4], P[B_+5]), b1 = cvt_pk_bf16(P[B_+6], P[B_+7]);                                             \
        auto r0 = __builtin_amdgcn_permlane32_swap(a0, b0, false, false); auto r1 = __builtin_amdgcn_permlane32_swap(a1, b1, false, false); \
        u32x4 w = {r0[0], r1[0], r0[1], r1[1]}; OUT = *reinterpret_cast<bf16x8*>(&w); } while (0)
    PK4(p0, 0, pa0); PK4(p0, 8, pa1); PK4(p1, 0, pa2); PK4(p1, 8, pa3);
#undef PK4
}
template <int KB>
__device__ __forceinline__ void qkt(f32x16& p0, f32x16& p1, const char* K_lds, int r32, int hi, const bf16x8* qr) {
    p0 = f32x16{}; p1 = f32x16{};
    const char* kb[4];
#pragma unroll
    for (int dd = 0; dd < 4; ++dd) kb[dd] = K_lds + KB * SHM_K + KSWZ(r32, (dd * 16 + hi * 8) * 2);
#pragma unroll
    for (int d0 = 0; d0 < 8; ++d0) { const char* a = kb[d0 & 3] + (d0 >> 2) * 128;
        bf16x8 b0 = *reinterpret_cast<const bf16x8*>(a);
        bf16x8 b1 = *reinterpret_cast<const bf16x8*>(a + 32 * 256);
        p0 = __builtin_amdgcn_mfma_f32_32x32x16_bf16(b0, qr[d0], p0, 0, 0, 0);
        p1 = __builtin_amdgcn_mfma_f32_32x32x16_bf16(b1, qr[d0], p1, 0, 0, 0); }
}
template <int VB>
__device__ __forceinline__ void pv_tile(f32x16* o, int vb0, bf16x8 pa0, bf16x8 pa1, bf16x8 pa2, bf16x8 pa3) {
#define TRRD(dst, off) asm volatile("ds_read_b64_tr_b16 %0, %1 offset:%2" : "=&v"(dst) : "v"(vb0), "i"(off) : "memory")
#define PV_D0(d0) do { s16x4 l0, l1, l2, l3, h0, h1, h2, h3; constexpr int b_ = VB * SHM_V + v_rd_off(d0, 0, 0); \
        TRRD(l0, b_); TRRD(h0, b_ + 2048); TRRD(l1, b_ + 4096); TRRD(h1, b_ + 6144); TRRD(l2, b_ + 8192); TRRD(h2, b_ + 10240); TRRD(l3, b_ + 12288); TRRD(h3, b_ + 14336); \
        asm volatile("s_waitcnt lgkmcnt(0)" ::: "memory"); SBAR();   \
        o[d0] = __builtin_amdgcn_mfma_f32_32x32x16_bf16((bf16x8){l0[0], l0[1], l0[2], l0[3], h0[0], h0[1], h0[2], h0[3]}, pa0, o[d0], 0, 0, 0);   \
        o[d0] = __builtin_amdgcn_mfma_f32_32x32x16_bf16((bf16x8){l1[0], l1[1], l1[2], l1[3], h1[0], h1[1], h1[2], h1[3]}, pa1, o[d0], 0, 0, 0);   \
        o[d0] = __builtin_amdgcn_mfma_f32_32x32x16_bf16((bf16x8){l2[0], l2[1], l2[2], l2[3], h2[0], h2[1], h2[2], h2[3]}, pa2, o[d0], 0, 0, 0);   \
        o[d0] = __builtin_amdgcn_mfma_f32_32x32x16_bf16((bf16x8){l3[0], l3[1], l3[2], l3[3], h3[0], h3[1], h3[2], h3[3]}, pa3, o[d0], 0, 0, 0); } while (0)
    PV_D0(0); PV_D0(1); PV_D0(2); PV_D0(3);
#undef PV_D0
#undef TRRD
}
__device__ __forceinline__ void mask_init(f32x16& p0, f32x16& p1, unsigned w0, unsigned w1, int dq, int hi, bool near, const float* tb, float mneg) {
    const unsigned mb = __float_as_uint(mneg);
    unsigned NEGINF = 0xff800000u; asm volatile("" : "+s"(NEGINF));
    const int n0 = (int)~(w0 >> (4 * hi)), n1 = (int)~(w1 >> (4 * hi));
#define MI_SEL(dst, n, c, val) { unsigned u_; asm("v_bfe_i32 %0, %1, " #c ", 1" : "=v"(u_) : "v"(n)); asm("v_bfi_b32 %0, %1, %2, %3" : "=v"(dst) : "v"(u_), "s"(NEGINF), "v"(val)); }
    if (near) {
        const float* tp = tb + ((((dq - 4 * hi) & 255) + 256 - 59));
#define MI_NEAR(r, c) { const float b0_ = tp[59 - c] + mneg, b1_ = tp[27 - c] + mneg; MI_SEL(p0[r], n0, c, b0_) MI_SEL(p1[r], n1, c, b1_) }
        MI_NEAR(0, 0) MI_NEAR(1, 1) MI_NEAR(2, 2) MI_NEAR(3, 3) MI_NEAR(4, 8) MI_NEAR(5, 9) MI_NEAR(6, 10) MI_NEAR(7, 11)
        MI_NEAR(8, 16) MI_NEAR(9, 17) MI_NEAR(10, 18) MI_NEAR(11, 19) MI_NEAR(12, 24) MI_NEAR(13, 25) MI_NEAR(14, 26) MI_NEAR(15, 27)
#undef MI_NEAR
    } else {
#define MI_FAR(r, c) { MI_SEL(p0[r], n0, c, mb) MI_SEL(p1[r], n1, c, mb) }
        MI_FAR(0, 0) MI_FAR(1, 1) MI_FAR(2, 2) MI_FAR(3, 3) MI_FAR(4, 8) MI_FAR(5, 9) MI_FAR(6, 10) MI_FAR(7, 11)
        MI_FAR(8, 16) MI_FAR(9, 17) MI_FAR(10, 18) MI_FAR(11, 19) MI_FAR(12, 24) MI_FAR(13, 25) MI_FAR(14, 26) MI_FAR(15, 27)
#undef MI_FAR
    }
#undef MI_SEL
}
template <int KB>
__device__ __forceinline__ void qkt_acc(f32x16& p0, f32x16& p1, const char* K_lds, int r32, int hi, const bf16x8* qr) {
    const char* kb[4];
#pragma unroll
    for (int dd = 0; dd < 4; ++dd) kb[dd] = K_lds + KB * SHM_K + KSWZ(r32, (dd * 16 + hi * 8) * 2);
#pragma unroll
    for (int d0 = 0; d0 < 8; ++d0) { const char* a = kb[d0 & 3] + (d0 >> 2) * 128;
        bf16x8 b0 = *reinterpret_cast<const bf16x8*>(a);
        bf16x8 b1 = *reinterpret_cast<const bf16x8*>(a + 32 * 256);
        p0 = __builtin_amdgcn_mfma_f32_32x32x16_bf16(b0, qr[d0], p0, 0, 0, 0);
        p1 = __builtin_amdgcn_mfma_f32_32x32x16_bf16(b1, qr[d0], p1, 0, 0, 0); }
}
struct KRing { bf16x8 f[3][2]; };
#define KSWZ16(row, colB) ((row) * 256 + ((colB) ^ (((row) & 15) << 4)))
struct KAddr { unsigned a[8]; };
__device__ __forceinline__ KAddr k_addr(int r32, int hi) { KAddr k;
#pragma unroll
    for (int d0 = 0; d0 < 8; ++d0) k.a[d0] = (unsigned)KSWZ16(r32, d0 * 32 + hi * 16);
    return k; }
template <int KB>
__device__ __forceinline__ void qkt_head(KRing& R, const LAS char* kl, const KAddr& ka) {
#pragma unroll
    for (int d0 = 0; d0 < 3; ++d0) { const LAS char* a = kl + ka.a[d0] + KB * SHM_K;
        R.f[d0][0] = *(const LAS bf16x8*)a; R.f[d0][1] = *(const LAS bf16x8*)(a + 32 * 256); }
}
template <int KB>
__device__ __forceinline__ void qkt_body(f32x16& p0, f32x16& p1, KRing& R, const LAS char* kl, const KAddr& ka, const bf16x8* qr) {
#pragma unroll
    for (int d0 = 0; d0 < 8; ++d0) {
        p0 = __builtin_amdgcn_mfma_f32_32x32x16_bf16(R.f[d0 % 3][0], qr[d0], p0, 0, 0, 0);
        p1 = __builtin_amdgcn_mfma_f32_32x32x16_bf16(R.f[d0 % 3][1], qr[d0], p1, 0, 0, 0);
        if (d0 < 5) { const LAS char* a = kl + ka.a[d0 + 3] + KB * SHM_K;
            R.f[d0 % 3][0] = *(const LAS bf16x8*)a; R.f[d0 % 3][1] = *(const LAS bf16x8*)(a + 32 * 256); }
        SBAR();
    }
}
struct BlockRef { const bf16_t* Q; const bf16_t* K; const bf16_t* V; bf16_t* O; const unsigned* M; int P0; };
struct Seam { bf16x8 qr[8]; u32x2 mw, mwn; };
#define VMWN(n) asm volatile("s_waitcnt vmcnt(%0)" :: "i"(n) : "memory")
#define ABAR() __builtin_amdgcn_s_barrier()
#define DMA_T(gb, off, dst) do { const GAS char* g0_ = (gb); const GAS char* g1_ = g0_ + 32 * 256; asm volatile("" : "+s"(g0_), "+s"(g1_)); LAS char* d_ = (dst); \
        __builtin_amdgcn_global_load_lds((const GAS unsigned*)(g0_ + (off)), (LAS unsigned*)d_, 16, 0, 0); \
        __builtin_amdgcn_global_load_lds((const GAS unsigned*)(g1_ + (off)), (LAS unsigned*)(d_ + 8192), 16, 0, 0); } while (0)
#define MLOADW(dst, base_u, off) asm volatile("s_nop 4\n\tglobal_load_dwordx2 %0, %1, %2" : "=v"(dst) : "v"(off), "s"(base_u) : "memory")
struct DmaLane { unsigned koff, voff; };
__device__ __forceinline__ DmaLane dma_lane(int tid) {
    DmaLane d; const unsigned t = (unsigned)tid, krow = t >> 4;
    d.koff = krow * 256u + (((t & 15u) << 4) ^ ((krow & 15u) << 4));
    const unsigned kk = (t >> 7) * 8 + ((t & 31u) >> 2), vk = (kk & ~0xCu) | ((kk & 4u) << 1) | ((kk & 8u) >> 1);
    d.voff = vk * 256u + ((((t >> 5) & 3u) * 32 + (t & 3u) * 8) * 2);
    return d;
}
constexpr size_t TILEB = (size_t)KVBLK * 256;
__device__ __forceinline__ void attn_prime(const BlockRef& cur, LAS char* ldsL, Seam& S, const int tid) {
    const int wid = __builtin_amdgcn_readfirstlane(tid >> 6), lane = tid & 63, r32 = lane & 31, hi = lane >> 5;
    const DmaLane dl = dma_lane(tid); const unsigned ldsw = (unsigned)wid * 1024u;
    const unsigned qoff = (unsigned)((r32 * LDZ + hi * 8) * 2);
    const GAS char* qb_ = (const GAS char*)(cur.Q + (size_t)(cur.P0 + wid * QBLK) * LDZ); asm volatile("" : "+s"(qb_));
#pragma unroll
    for (int d0 = 0; d0 < 8; ++d0) S.qr[d0] = *(const GAS bf16x8*)(qb_ + d0 * 32 + qoff);
    { const GAS char* mr_ = (const GAS char*)(cur.M + (size_t)(cur.P0 + wid * QBLK) * 128); asm volatile("" : "+s"(mr_));
      const unsigned mo0 = (unsigned)(r32 * 512), mo1 = mo0 + 8u; MLOADW(S.mw, mr_, mo0); MLOADW(S.mwn, mr_, mo1); }
    DMA_T((const GAS char*)cur.K, dl.koff, ldsL + KRING + ldsw);            DMA_T((const GAS char*)cur.V, dl.voff, ldsL + ldsw);
    DMA_T((const GAS char*)cur.K + TILEB, dl.koff, ldsL + KRING + SHM_K + ldsw); DMA_T((const GAS char*)cur.V + TILEB, dl.voff, ldsL + SHM_V + ldsw);
    asm volatile("s_waitcnt vmcnt(0) lgkmcnt(0)" ::: "memory"); asm volatile("" : "+v"(S.mw), "+v"(S.mwn)); ABAR();
    DMA_T((const GAS char*)cur.K + 2 * TILEB, dl.koff, ldsL + KRING + 2 * SHM_K + ldsw); DMA_T((const GAS char*)cur.V + 2 * TILEB, dl.voff, ldsL + 2 * SHM_V + ldsw);
}
__device__ __forceinline__ void attn_block(const BlockRef& cur, const BlockRef& nxt, char* lds, LAS char* ldsL, Seam& S, const int tid) {
    const int wid = __builtin_amdgcn_readfirstlane(tid >> 6), lane = tid & 63, r32 = lane & 31, hi = lane >> 5;
    const int NT = cur.P0 / KVBLK + 4;
    const int qlo = cur.P0 + wid * QBLK, qpos = qlo + r32;
    char* V_lds = lds; char* K_lds = lds + KRING;
    float* ws = (float*)(lds + WS_OFF) + wid * 64; float* li_l = ws; float* al_l = ws + 32;
    const float* tb = (const float*)(lds + TB_OFF);
    const GAS char* mrow_u = (const GAS char*)(cur.M + (size_t)qlo * 128); asm volatile("" : "+s"(mrow_u));
    const GAS char* nrow_u = (const GAS char*)(nxt.M + (size_t)(nxt.P0 + wid * QBLK) * 128); asm volatile("" : "+s"(nrow_u));
    const unsigned moff = (unsigned)(r32 * 512);
    float m_reg = 0.f, l_reg = 0; f32x16 o[4] = {};
    const DmaLane dl = dma_lane(tid); const unsigned ldsw = (unsigned)wid * 1024u;
    LAS char* const dK = ldsL + KRING + ldsw; LAS char* const dV = ldsL + ldsw;
    const GAS char* const cK = (const GAS char*)cur.K; const GAS char* const cV = (const GAS char*)cur.V; const GAS char* const nK = (const GAS char*)nxt.K; const GAS char* const nV = (const GAS char*)nxt.V;
    const int vb0 = (int)(uintptr_t)V_lds + v_rd_base(lane);
    const LAS char* const kl = ldsL + KRING; const KAddr ka = k_addr(r32, hi);
#define RESC(a) do { if (__any((a) < 1.f)) { _Pragma("unroll") for (int d_ = 0; d_ < 4; ++d_) _Pragma("unroll") for (int r = 0; r < 16; ++r) o[d_][r] *= (a); } } while (0)
#define MINIT(P0_, P1_, t) do { const int kb_ = (t) * KVBLK; mask_init(P0_, P1_, mw.x, mw.y, qpos - kb_, hi, kb_ > qlo - 192, tb, -m_reg); } while (0)
#define ISSUE(t, PB) do { const int jm_ = (t) + 2, jt_ = (t) + 3;                                                                               \
        { const GAS char* mb_ = jm_ < NT ? mrow_u : nrow_u; const unsigned mo_ = moff + 8u * (unsigned)(jm_ < NT ? jm_ : jm_ - NT); MLOADW(mwn, mb_, mo_); }   \
        DMA_T(jt_ < NT ? cK + (size_t)jt_ * TILEB : nK + (size_t)(jt_ - NT) * TILEB, dl.koff, dK + (PB) * SHM_K);                             \
        DMA_T(jt_ < NT ? cV + (size_t)jt_ * TILEB : nV + (size_t)(jt_ - NT) * TILEB, dl.voff, dV + (PB) * SHM_V); } while (0)
#define CLOSE() do { VMWN(4); asm volatile("" : "+v"(mwn)); mw = mwn; ABAR(); } while (0)
    f32x16 pA0, pA1, pB0, pB1; float mnA, mnB, alA, alB; bf16x8 pa0, pa1, pa2, pa3;
    u32x2 mw = S.mw, mwn = S.mwn;
    KRing R;
    qkt_head<0>(R, kl, ka); SBAR();
    MINIT(pA0, pA1, 0);
    SBAR(); qkt_body<0>(pA0, pA1, R, kl, ka, S.qr);
    partialSM(pA0, pA1, m_reg, l_reg, alA); SBAR();
    CLOSE(); ISSUE(0, 3); SBAR();
#define STEP(PX0, PX1, mnX, alX, PY0, PY1, alY, t, B, PB) do {                                                                 \
        qkt_head<B>(R, kl, ka); SBAR();                                                                                          \
        MINIT(PX0, PX1, (t));                                                                                                 \
        SBAR(); qkt_body<B>(PX0, PX1, R, kl, ka, S.qr);                                                                          \
        finishSM(PY0, PY1, alY, l_reg, pa0, pa1, pa2, pa3); SBAR();                                                           \
        pv_tile<PB>(o, vb0, pa0, pa1, pa2, pa3); partialSM(PX0, PX1, m_reg, l_reg, alX);                                        \
        RESC(alX); SBAR();                                                                                                    \
        CLOSE(); ISSUE((t), PB); SBAR(); } while (0)
    int t = 1;
    for (; t + 3 < NT; t += 4) {
        STEP(pB0, pB1, mnB, alB, pA0, pA1, alA, t, 1, 0);
        STEP(pA0, pA1, mnA, alA, pB0, pB1, alB, t + 1, 2, 1);
        STEP(pB0, pB1, mnB, alB, pA0, pA1, alA, t + 2, 3, 2);
        STEP(pA0, pA1, mnA, alA, pB0, pB1, alB, t + 3, 0, 3);
    }
    STEP(pB0, pB1, mnB, alB, pA0, pA1, alA, NT - 3, 1, 0);
    STEP(pA0, pA1, mnA, alA, pB0, pB1, alB, NT - 2, 2, 1);
    STEP(pB0, pB1, mnB, alB, pA0, pA1, alA, NT - 1, 3, 2);
    { const GAS char* qb_ = (const GAS char*)(nxt.Q + (size_t)(nxt.P0 + wid * QBLK) * LDZ); asm volatile("" : "+s"(qb_));
      int t2 = tid; asm volatile("" : "+v"(t2));
      const unsigned qoff2 = (unsigned)((((t2 & 31) * LDZ) + ((t2 >> 5) & 1) * 8) * 2);
#pragma unroll
      for (int d0 = 0; d0 < 8; ++d0) S.qr[d0] = *(const GAS bf16x8*)(qb_ + d0 * 32 + qoff2); }
    SBAR();
    finishSM(pB0, pB1, alB, l_reg, pa0, pa1, pa2, pa3); SBAR(); pv_tile<3>(o, vb0, pa0, pa1, pa2, pa3);
    {
        const float rl = __builtin_amdgcn_rcpf(l_reg);
        bf16_t* Ow = cur.O + (size_t)(cur.P0 + wid * QBLK + r32) * 1024 + hi * 8;
#pragma unroll
        for (int d0 = 0; d0 < 4; ++d0)
#pragma unroll
            for (int pr = 0; pr < 2; ++pr) {
                const int rb = 8 * pr;
                unsigned a0 = cvt_pk_bf16(o[d0][rb + 0] * rl, o[d0][rb + 1] * rl), a1 = cvt_pk_bf16(o[d0][rb + 2] * rl, o[d0][rb + 3] * rl);
                unsigned b0 = cvt_pk_bf16(o[d0][rb + 4] * rl, o[d0][rb + 5] * rl), b1 = cvt_pk_bf16(o[d0][rb + 6] * rl, o[d0][rb + 7] * rl);
                auto s0 = __builtin_amdgcn_permlane32_swap(a0, b0, false, false); auto s1 = __builtin_amdgcn_permlane32_swap(a1, b1, false, false);
                *(u32x4*)(Ow + d0 * 32 + 16 * pr) = (u32x4){s0[0], s1[0], s0[1], s1[1]};
            }
    }
    S.mw = mw; S.mwn = mwn;
#undef RESC
#undef MINIT
#undef STEP
#undef ISSUE
#undef CLOSE
}
__device__ __forceinline__ void attn_item(char* lds, LAS char* ldsL, const bf16_t* Z, const bf16_t* KVC, const unsigned* mask, const float* rel_bias, bf16_t* YB, int b, int h, int x, const int tid_in) {
    int tid = tid_in; asm volatile("" : "+v"(tid));
    float* tb = (float*)(lds + TB_OFF);
    __syncthreads();
    if (tid < 256) {
        float v = 0.f;
        if (tid < 128) { int bk = tid; if (tid >= 16) { bk = 16 + (int)(__logf((float)tid * (1.f / 16.f)) * (16.f / 2.0794415416798357f)); bk = bk > 31 ? 31 : bk; }
            v = (rel_bias[bk * NHEAD + h] - rel_bias[31 * NHEAD + h]) * 1.4426950408889634f; }
        tb[tid] = v; tb[256 + tid] = v;
    }
    BlockRef c0, c1;
    c0.Q = Z + (size_t)b * SEQ * LDZ + ZQ + h * D; c0.K = KVC + ((size_t)b * NHEAD + h) * ((size_t)SEQ * 128); c0.V = KVC + ((size_t)(NB + b) * NHEAD + h) * ((size_t)SEQ * 128);
    c0.O = YB + (size_t)b * SEQ * 1024 + h * D; c0.M = mask + (size_t)b * SEQ * 128; c0.P0 = (15 - x) * QB;
    c1 = c0; c1.P0 = x * QB;
    Seam S;
    attn_prime(c0, ldsL, S, tid);
    attn_block(c0, c1, lds, ldsL, S, tid);
    attn_block(c1, c1, lds, ldsL, S, tid);
    asm volatile("s_waitcnt vmcnt(0)" ::: "memory");
    asm volatile("" :: "v"(S.mw), "v"(S.mwn));
}
#undef VMWN
#undef ABAR
#undef DMA_T
#undef MLOADW
}


#if defined(REF_IDX) || defined(REF_ATT)
__device__ __forceinline__ float bf2f(bf16_t v) { return __uint_as_float((unsigned)v << 16); }
__global__ void __launch_bounds__(256) ref_indexer(const bf16_t* Z, unsigned* mask) {
    __shared__ float q[1024]; __shared__ float w[16]; __shared__ unsigned keys[4096]; __shared__ unsigned cnt;
    const int row = blockIdx.x, b = row / SEQ, t = row % SEQ, tid = threadIdx.x;
    const bf16_t* zr = Z + (size_t)row * LDZ;
    for (int i = tid; i < 1024; i += 256) q[i] = bf2f(zr[ZQI + i]);
    if (tid < 16) w[tid] = bf2f(zr[ZWI + tid]) * 0.25f;
    __syncthreads();
    for (int s = tid; s < SEQ; s += 256) {
        unsigned k = 0u;
        if (s <= t) {
            const bf16_t* kr = Z + (size_t)(b * SEQ + s) * LDZ + ZKI;
            float kv[64];
            for (int d = 0; d < 64; ++d) kv[d] = bf2f(kr[d]);
            float sc = 0.f;
            for (int h = 0; h < 16; ++h) { float dot = 0.f; for (int d = 0; d < 64; ++d) dot += q[h * 64 + d] * kv[d]; dot *= 0.125f; sc += (dot > 0.f ? dot : 0.f) * w[h]; }
            const unsigned u = __float_as_uint(sc); k = u ^ ((unsigned)((int)u >> 31) | 0x80000000u);
        }
        keys[s] = k;
    }
    __syncthreads();
    unsigned T = 0u;
    for (int bit = 31; bit >= 0; --bit) {
        const unsigned cand = T | (1u << bit);
        if (tid == 0) cnt = 0u;
        __syncthreads();
        unsigned c = 0u; for (int s = tid; s < SEQ; s += 256) c += keys[s] >= cand ? 1u : 0u;
        atomicAdd(&cnt, c);
        __syncthreads();
        if (cnt >= 256u) T = cand;
        __syncthreads();
    }
    if (T == 0u) T = 1u;
    if (tid < 128) { unsigned word = 0u; for (int j = 0; j < 32; ++j) word |= (keys[tid * 32 + j] >= T ? 1u : 0u) << j; mask[(size_t)row * 128 + tid] = word; }
}
__global__ void __launch_bounds__(256) ref_attention(const bf16_t* Z, const unsigned* mask, const float* rel_bias, bf16_t* YB) {
    const int gw = blockIdx.x * 4 + (threadIdx.x >> 6), lane = threadIdx.x & 63;
    const int row = gw >> 3, h = gw & 7, b = row / SEQ, t = row % SEQ;
    const bf16_t* zr = Z + (size_t)row * LDZ + ZQ + h * 128;
    const float q0 = bf2f(zr[2 * lane]), q1 = bf2f(zr[2 * lane + 1]);
    float m = -1e30f, l = 0.f, a0 = 0.f, a1 = 0.f;
    for (int wi = 0; wi < 128; ++wi) {
        unsigned word = mask[(size_t)row * 128 + wi];
        while (word) {
            const int j = __builtin_ctz(word); word &= word - 1;
            const int s = wi * 32 + j;
            const bf16_t* kr = Z + (size_t)(b * SEQ + s) * LDZ + ZK + h * 128; const bf16_t* vr = Z + (size_t)(b * SEQ + s) * LDZ + ZVV + h * 128;
            float d = q0 * bf2f(kr[2 * lane]) + q1 * bf2f(kr[2 * lane + 1]);
            for (int o = 1; o < 64; o <<= 1) d += __shfl_xor(d, o);
            int n = t - s; if (n < 0) n = 0; int bk = n; if (n >= 16) { bk = 16 + (int)(logf((float)n / 16.f) / 2.0794415416798357f * 16.f); bk = bk > 31 ? 31 : bk; }
            const float lg = d * 0.08838834764831845f + rel_bias[bk * NHEAD + h];
            const float mn = fmaxf(m, lg), al = expf(m - mn), p = expf(lg - mn);
            l = l * al + p; a0 = a0 * al + p * bf2f(vr[2 * lane]); a1 = a1 * al + p * bf2f(vr[2 * lane + 1]); m = mn;
        }
    }
    *(unsigned*)(YB + (size_t)row * 1024 + h * 128 + 2 * lane) = cvt_pk_bf16(a0 / l, a1 / l);
}
#endif

constexpr int PH_PER_LAYER = 14, N_PHASES = PH_PER_LAYER * DEPTH;
__global__ void __launch_bounds__(NWAVES * 64, 2) mk_fwd(Args args) {
    extern __shared__ __attribute__((aligned(16))) unsigned char lds[];
    Frame F;
    F.lds = (LAS unsigned char*)lds;
    F.wave = __builtin_amdgcn_readfirstlane(threadIdx.x >> 6);
    F.G = gridDim.x; { const int bx = blockIdx.x; F.vcu = (F.G % 8 == 0) ? (bx % 8) * (F.G / 8) + bx / 8 : bx; }
    unsigned char* ws = args.ws;
    for (int u = threadIdx.x; u < (LDS_BYTES - LDSCTL_OFF) / 4; u += NWAVES * 64) ((LAS unsigned*)(F.lds + LDSCTL_OFF))[u] = 0u;
    __syncthreads();
    volatile LAS unsigned* MISC = (volatile LAS unsigned*)(F.lds + MISC_OFF);
    XcdBarrier bar; bar.bar = (unsigned*)(ws + WS_CTL) + CW_BAR; bar.x = 0; bar.st = nullptr;
#if MK_N_LAUNCHES == 1
    bar = xcd_barrier_post((unsigned*)(ws + WS_CTL) + CW_BAR, MISC + 8, (int)threadIdx.x);
#define GRID_BAR() do { size_t zb = 0; asm volatile("" : "+s"(zb)); XcdBarrier b2 = bar; b2.bar = bar.bar + zb; b2.x = bar.x + (unsigned)zb; xcd_barrier(b2, frame_tid(F)); } while (0)
#else
#define GRID_BAR() do { } while (0)
#endif
    const int lo = args.ph_lo, hi = args.ph_hi;
#define IN(k) (lo <= (k) && (k) < hi)
#define SEAM(k) do { if (IN(k) && IN((k) + 1)) GRID_BAR(); } while (0)

#define PH_PTRS size_t zl = 0; asm volatile("" : "+s"(zl)); int tz = frame_tid(F); asm volatile("" : "+v"(tz)); unsigned char* wsl = args.ws + zl; \
    bf16_t* Hb = (bf16_t*)(wsl + WS_H); bf16_t* Fb = (bf16_t*)(wsl + WS_F); bf16_t* Zb = (bf16_t*)(wsl + WS_Z); \
    bf16_t* YA = (bf16_t*)(wsl + WS_YA); bf16_t* YB = (bf16_t*)(wsl + WS_YB); unsigned* MASK = (unsigned*)(wsl + WS_MASK); float* X = args.out + zl; bf16_t* XB = (bf16_t*)(wsl + WS_XB); float* RS = (float*)(wsl + WS_RS); \
    (void)Hb; (void)Fb; (void)Zb; (void)YA; (void)YB; (void)MASK; (void)X; (void)XB; (void)RS;

    for (int l = 0; l < DEPTH; ++l) {
        const int pb = PH_PER_LAYER * l;
        if (pb >= hi || pb + PH_PER_LAYER <= lo) continue;
        if (PH_ON(0) && IN(pb + 0)) for (int rep_ = 0; rep_ < PH_REP(0); ++rep_) {
            PH_PTRS
#define MK_LAYERW(L, ll) LayerW L; L.f1i = (args.in[3] + zl) + (size_t)(ll) * DM * NFF; L.f1o = (args.in[4] + zl) + (size_t)(ll) * FF * DM; L.f2i = (args.in[19] + zl) + (size_t)(ll) * DM * NFF; L.f2o = (args.in[20] + zl) + (size_t)(ll) * FF * DM; \
            L.win = (args.in[7] + zl) + (size_t)(ll) * DM * INCOLS; L.wg = (args.in[15] + zl) + (size_t)(ll) * DM * 2 * DM; L.wa = (args.in[13] + zl) + (size_t)(ll) * SGW * DM; L.wb = (args.in[14] + zl) + (size_t)(ll) * 1024 * DM; L.wo = (args.in[16] + zl) + (size_t)(ll) * DM * DM; \
            L.wss = (args.in[10] + zl) + (size_t)(ll) * 8 * 128 * 128; L.g_f1 = (args.in[1] + zl) + (size_t)(ll) * DM; L.g_f2 = (args.in[17] + zl) + (size_t)(ll) * DM; L.g_mix = (args.in[5] + zl) + (size_t)(ll) * DM; \
            L.f8_1 = (F8_MASK >> (2 * (ll))) & 1; L.f8_2 = (F8_MASK >> (2 * (ll) + 1)) & 1; L.q8_1 = (I8_MASK >> (2 * (ll))) & 1; L.q8_2 = (I8_MASK >> (2 * (ll) + 1)) & 1; L.q8_m = (I8_MASK >> (4 + (ll))) & 1;
            if (l == 0) { MK_LAYERW(L, l) conv_phase(F, L, wsl, tz, F.vcu, F.G, 0, CV_S1); conv_phase(F, L, wsl, tz, F.vcu, F.G, CV_S2, CV_END); }
            if (l == 0) thin_phase(F, (args.in[0] + zl), XB, nullptr, nullptr, 0.f, RS, nullptr, ((I8_MASK >> 0) & 1) ? (unsigned char*)Hb : nullptr, tz);
        }
        if (l == 0) SEAM(pb + 0);
        if (PH_ON(1) && IN(pb + 1)) for (int rep_ = 0; rep_ < PH_REP(1); ++rep_) {
            PH_PTRS
            pg8::StaticOrder S; S.init(MT, NFF, F.G, (int)blockIdx.x);
            constexpr bool ANY_I8 = (I8_MASK & 0x5) != 0, ANY_B16 = (~I8_MASK & 0x5) != 0;
            const bool q8 = (I8_MASK >> (2 * l)) & 1, o8 = (F8_MASK >> (2 * l)) & 1;
            if (ANY_I8 && q8) {
                pg8::Gemm g{Hb, (bf16_t*)(wsl + WS_WF1I), MT, NFF, DM};
                if (o8) { pg8::Epi<5, true> E{Zb, FF, nullptr, 0, RS + MT, F8_SG, 1.f / I8_SWQ}; pg8::gemm_phase<pg8::Epi<5, true>, pg8::StaticOrder, true, true, 2>(F.lds, g, S, E, tz); }
                else { pg8::Epi<1, true> E{Zb, FF, nullptr, 0, RS + MT, 1.f, 1.f / I8_SWQ}; pg8::gemm_phase<pg8::Epi<1, true>, pg8::StaticOrder, true, true, 2>(F.lds, g, S, E, tz); }
            } else if (ANY_B16) {
                pg8::Gemm g{XB, (bf16_t*)(wsl + WS_WF1I), MT, NFF, DM};
                if (o8) { pg8::Epi<5> E{Zb, FF, nullptr, 0, RS, F8_SG, 1.f}; pg8::gemm_phase<pg8::Epi<5>, pg8::StaticOrder, true, true>(F.lds, g, S, E, tz); }
                else { pg8::Epi<1> E{Zb, FF, nullptr, 0, RS, 1.f, 1.f}; pg8::gemm_phase<pg8::Epi<1>, pg8::StaticOrder, true, true>(F.lds, g, S, E, tz); }
            }
        }
        SEAM(pb + 1);
        if (PH_ON(2) && IN(pb + 2)) for (int rep_ = 0; rep_ < PH_REP(2); ++rep_) {
            PH_PTRS
            pg8::Gemm g{Zb, (bf16_t*)(wsl + WS_WF1O), MT, DM, FF}; pg8::StaticOrder S; S.init(MT, DM, F.G, (int)blockIdx.x);
            if ((F8_MASK >> (2 * l)) & 1) { pg8::Epi<0> E{Fb, DM, nullptr, 0, nullptr, 1.f / (F8_SG * F8_SW), 1.f}; pg8::gemm_phase<pg8::Epi<0>, pg8::StaticOrder, true, true, 1>(F.lds, g, S, E, tz); }
            else { pg8::Epi<0> E{Fb, DM, nullptr, 0, nullptr, 1.f, 1.f}; pg8::gemm_phase<pg8::Epi<0>, pg8::StaticOrder, true, true>(F.lds, g, S, E, tz); }
        }
        SEAM(pb + 2);
        if (PH_ON(3) && IN(pb + 3)) for (int rep_ = 0; rep_ < PH_REP(3); ++rep_) { PH_PTRS thin_phase(F, nullptr, XB, Fb, (args.in[2] + zl) + (size_t)l * DM, 0.5f, RS, nullptr, ((I8_MASK >> (4 + l)) & 1) ? (unsigned char*)Hb : nullptr, tz); }
        SEAM(pb + 3);
        if (PH_ON(4) && IN(pb + 4)) for (int rep_ = 0; rep_ < PH_REP(4); ++rep_) {
            PH_PTRS
            pg8::StaticOrder S; S.init(MT, LDZ, F.G, (int)blockIdx.x);
            constexpr bool ANY_I8 = (I8_MASK & 0x30) != 0, ANY_B16 = (~I8_MASK & 0x30) != 0;
            if (ANY_I8 && ((I8_MASK >> (4 + l)) & 1)) { pg8::Gemm g{Hb, (bf16_t*)(wsl + WS_WMIX), MT, LDZ, DM}; pg8::Epi<2, true> E{Zb, LDZ, Fb, 0, RS + MT, 1.f, 1.f / I8_SWQ}; pg8::gemm_phase<pg8::Epi<2, true>, pg8::StaticOrder, true, true, 2>(F.lds, g, S, E, tz); }
            else if (ANY_B16) { pg8::Gemm g{XB, (bf16_t*)(wsl + WS_WMIX), MT, LDZ, DM}; pg8::Epi<2> E{Zb, LDZ, Fb, 0, RS, 1.f, 1.f}; pg8::gemm_phase<pg8::Epi<2>, pg8::StaticOrder, true, true>(F.lds, g, S, E, tz); }
            constexpr int BUSY = (MT / 256) * (LDZ / 256) % 256;
            if (BUSY != 0 && (int)blockIdx.x >= BUSY && F.G == 256) {
                { MK_LAYERW(L2, l) conv_phase(F, L2, wsl, tz, (int)blockIdx.x - BUSY, 256 - BUSY, CV_S1, CV_S2); }
            } else if (F.G != 256 || BUSY == 0) {
                { MK_LAYERW(L2, l) conv_phase(F, L2, wsl, tz, F.vcu, F.G, CV_S1, CV_S2); }
            }
        }
        SEAM(pb + 4);
        if (PH_ON(5) && IN(pb + 5)) for (int rep_ = 0; rep_ < PH_REP(5); ++rep_) {
            PH_PTRS
#ifndef NO_IDX
            for (int rep2_ = 0; rep2_ < DUP_IDX; ++rep2_)
            for (int u = F.vcu; u < 1024; u += F.G) {
                const int i = u >> 8, c = u & 255; const int jj = (c + 128 * (i >> 1)) & 255; const int j = (i & 1) ? 255 - jj : jj;
                indexer_unit(F.lds, Zb, MASK, i, 16 * j, F.wave, tz);
            }
#endif
            const float* lng = (args.in[8] + zl) + (size_t)l * SGW; const float* lnb = (args.in[9] + zl) + (size_t)l * SGW;
            const bf16_t* wsb = (const bf16_t*)(wsl + WS_WSB); const float* bss = (args.in[11] + zl) + (size_t)l * 8 * 128;
            for (int rep3_ = 0; rep3_ < DUP_SGU; ++rep3_)
            for (int u = F.vcu; u < 256; u += F.G) sgu_unit(F, Zb, YA, lng, lnb, wsb, bss, u >> 6, (u >> 1) & 31, u & 1, tz);
        }
        SEAM(pb + 5);
        if (PH_ON(6) && IN(pb + 6)) for (int rep_ = 0; rep_ < PH_REP(6); ++rep_) {
            PH_PTRS
            for (int it = F.vcu; it < 256; it += F.G) {
                const int b = it >> 6, h = (it >> 3) & 7, x = it & 7;
                att::attn_item((char*)lds, (LAS char*)F.lds, Zb, Fb, MASK, (args.in[12] + zl), YB, b, h, x, frame_tid(F));
            }
            __syncthreads();
        }
        SEAM(pb + 6);
        if (PH_ON(7) && IN(pb + 7)) for (int rep_ = 0; rep_ < PH_REP(7); ++rep_) {
            PH_PTRS
            pg8::Gemm g{YA, (bf16_t*)(wsl + WS_WA), MT, DM, SGW}; pg8::StaticOrder S; S.init(MT, DM, F.G, (int)blockIdx.x);
            pg8::Epi<3> E{Hb, DM, Zb + ZG, LDZ, nullptr, 1.f, 1.f};
            pg8::gemm_phase<pg8::Epi<3>, pg8::StaticOrder, true, true>(F.lds, g, S, E, tz);
        }
        if (PH_ON(8) && IN(pb + 8)) for (int rep_ = 0; rep_ < PH_REP(8); ++rep_) {
            PH_PTRS
            pg8::Gemm g{YB, (bf16_t*)(wsl + WS_WB), MT, DM, 1024}; pg8::StaticOrder S; S.init(MT, DM, F.G, (int)blockIdx.x);
            pg8::Epi<4> E{Hb, DM, Zb + ZG + DM, LDZ, nullptr, 1.f, 1.f};
            pg8::gemm_phase<pg8::Epi<4>, pg8::StaticOrder, true, true>(F.lds, g, S, E, tz);
        }
        SEAM(pb + 8);
        if (PH_ON(9) && IN(pb + 9)) for (int rep_ = 0; rep_ < PH_REP(9); ++rep_) {
            PH_PTRS
            pg8::Gemm g{Hb, (bf16_t*)(wsl + WS_WO), MT, DM, DM}; pg8::StaticOrder S; S.init(MT, DM, F.G, (int)blockIdx.x);
            pg8::Epi<0> E{Fb, DM, nullptr, 0, nullptr, 1.f, 1.f};
            pg8::gemm_phase<pg8::Epi<0>, pg8::StaticOrder, true, true>(F.lds, g, S, E, tz);
        }
        SEAM(pb + 9);
        if (PH_ON(10) && IN(pb + 10)) for (int rep_ = 0; rep_ < PH_REP(10); ++rep_) { PH_PTRS thin_phase(F, nullptr, XB, Fb, (args.in[6] + zl) + (size_t)l * DM, 1.0f, RS, nullptr, ((I8_MASK >> (2 * l + 1)) & 1) ? (unsigned char*)Hb : nullptr, tz); }
        SEAM(pb + 10);
        if (PH_ON(11) && IN(pb + 11)) for (int rep_ = 0; rep_ < PH_REP(11); ++rep_) {
            PH_PTRS
            pg8::StaticOrder S; S.init(MT, NFF, F.G, (int)blockIdx.x);
            constexpr bool ANY_I8 = (I8_MASK & 0xA) != 0, ANY_B16 = (~I8_MASK & 0xA) != 0;
            const bool q8 = (I8_MASK >> (2 * l + 1)) & 1, o8 = (F8_MASK >> (2 * l + 1)) & 1;
            if (ANY_I8 && q8) {
                pg8::Gemm g{Hb, (bf16_t*)(wsl + WS_WF2I), MT, NFF, DM};
                if (o8) { pg8::Epi<5, true> E{Zb, FF, nullptr, 0, RS + MT, F8_SG, 1.f / I8_SWQ}; pg8::gemm_phase<pg8::Epi<5, true>, pg8::StaticOrder, true, true, 2>(F.lds, g, S, E, tz); }
                else { pg8::Epi<1, true> E{Zb, FF, nullptr, 0, RS + MT, 1.f, 1.f / I8_SWQ}; pg8::gemm_phase<pg8::Epi<1, true>, pg8::StaticOrder, true, true, 2>(F.lds, g, S, E, tz); }
            } else if (ANY_B16) {
                pg8::Gemm g{XB, (bf16_t*)(wsl + WS_WF2I), MT, NFF, DM};
                if (o8) { pg8::Epi<5> E{Zb, FF, nullptr, 0, RS, F8_SG, 1.f}; pg8::gemm_phase<pg8::Epi<5>, pg8::StaticOrder, true, true>(F.lds, g, S, E, tz); }
                else { pg8::Epi<1> E{Zb, FF, nullptr, 0, RS, 1.f, 1.f}; pg8::gemm_phase<pg8::Epi<1>, pg8::StaticOrder, true, true>(F.lds, g, S, E, tz); }
            }
        }
        SEAM(pb + 11);
        if (PH_ON(12) && IN(pb + 12)) for (int rep_ = 0; rep_ < PH_REP(12); ++rep_) {
            PH_PTRS
            pg8::Gemm g{Zb, (bf16_t*)(wsl + WS_WF2O), MT, DM, FF}; pg8::StaticOrder S; S.init(MT, DM, F.G, (int)blockIdx.x);
            if ((F8_MASK >> (2 * l + 1)) & 1) { pg8::Epi<0> E{Fb, DM, nullptr, 0, nullptr, 1.f / (F8_SG * F8_SW), 1.f}; pg8::gemm_phase<pg8::Epi<0>, pg8::StaticOrder, true, true, 1>(F.lds, g, S, E, tz); }
            else { pg8::Epi<0> E{Fb, DM, nullptr, 0, nullptr, 1.f, 1.f}; pg8::gemm_phase<pg8::Epi<0>, pg8::StaticOrder, true, true>(F.lds, g, S, E, tz); }
        }
        SEAM(pb + 12);
        if (PH_ON(13) && IN(pb + 13)) for (int rep_ = 0; rep_ < PH_REP(13); ++rep_) { PH_PTRS thin_phase(F, nullptr, XB, Fb, (args.in[18] + zl) + (size_t)l * DM, 0.5f, RS, (l + 1 < DEPTH) ? nullptr : X, (l + 1 < DEPTH && ((I8_MASK >> (2 * l + 2)) & 1)) ? (unsigned char*)Hb : nullptr, tz);
            if (l + 1 < DEPTH) { MK_LAYERW(LN, l + 1) conv_phase(F, LN, wsl, tz, F.vcu, F.G, 0, CV_S1); conv_phase(F, LN, wsl, tz, F.vcu, F.G, CV_S2, CV_END); } }
        SEAM(pb + 13);
    }
#undef IN
#undef SEAM
}

extern "C" void kernel_launch(void* const* d_in, const int* in_sizes, int n_in, void* d_out, int out_size, void* d_ws, size_t ws_size, hipStream_t stream) {
    static int grid = 0;
    if (grid == 0) {
        if (n_in != 21 || out_size != MT * DM || ws_size < WS_END) { fprintf(stderr, "kernel_launch: unexpected shapes (n_in %d out %d ws %zu, need %zu)\n", n_in, out_size, ws_size, (size_t)WS_END); grid = -1; return; }
        int dev = 0, cus = 0, per_cu = 0;
        if (hipGetDevice(&dev) != hipSuccess || hipDeviceGetAttribute(&cus, hipDeviceAttributeMultiprocessorCount, dev) != hipSuccess) { grid = -1; return; }
        if (hipFuncSetAttribute((const void*)mk_fwd, hipFuncAttributeMaxDynamicSharedMemorySize, LDS_BYTES) != hipSuccess) { fprintf(stderr, "kernel_launch: hipFuncSetAttribute failed\n"); grid = -1; return; }
        if (hipOccupancyMaxActiveBlocksPerMultiprocessor(&per_cu, (const void*)mk_fwd, NWAVES * 64, LDS_BYTES) != hipSuccess || per_cu < 1) { fprintf(stderr, "kernel_launch: occupancy query says %d\n", per_cu); }
        (void)hipGetLastError();
        grid = cus;
    }
    if (grid < 0) return;
    (void)hipMemsetAsync((char*)d_ws + WS_CTL, 0, CTL_BYTES, stream);
    Args a{};
    for (int i = 0; i < 21; ++i) a.in[i] = (const float*)d_in[i];
    a.out = (float*)d_out; a.ws = (unsigned char*)d_ws;
#if MK_N_LAUNCHES == 1
    a.ph_lo = 0; a.ph_hi = N_PHASES;
    hipLaunchKernelGGL(mk_fwd, dim3(grid), dim3(NWAVES * 64), LDS_BYTES, stream, a);
#else
    for (int p = 0; p < N_PHASES; ++p) { a.ph_lo = p; a.ph_hi = p + 1; hipLaunchKernelGGL(mk_fwd, dim3(grid), dim3(NWAVES * 64), LDS_BYTES, stream, a);
#ifdef REF_IDX
        if (p % PH_PER_LAYER == 5) hipLaunchKernelGGL(ref_indexer, dim3(MT), dim3(256), 0, stream, (const bf16_t*)((char*)d_ws + WS_Z), (unsigned*)((char*)d_ws + WS_MASK));
#endif
#ifdef REF_ATT
        if (p % PH_PER_LAYER == 6) hipLaunchKernelGGL(ref_attention, dim3(MT * 8 / 4), dim3(256), 0, stream, (const bf16_t*)((char*)d_ws + WS_Z), (const unsigned*)((char*)d_ws + WS_MASK), (const float*)d_in[12], (bf16_t*)((char*)d_ws + WS_YB));
#endif
    }
#endif
}
```

```cpp
#include <hip/hip_runtime.h>
#include <cstdio>
#include <cstdint>

#define DUP_IDX 1
#define DUP_SGU 1
#ifndef DUP_MASK
#define DUP_MASK 0x0
#endif
#define PH_REP(k) (((DUP_MASK >> (k)) & 1) ? 2 : 1)
#ifndef SKIP_MASK
#define SKIP_MASK 0x0
#endif
#define PH_ON(k) (!((SKIP_MASK >> (k)) & 1))
#ifndef MK_N_LAUNCHES
#define MK_N_LAUNCHES 1
#endif

#define LAS __attribute__((address_space(3)))
#define GAS __attribute__((address_space(1)))
typedef unsigned short bf16_t;
typedef short bf16x8 __attribute__((ext_vector_type(8)));
typedef short s16x4 __attribute__((ext_vector_type(4)));
typedef float f32x4 __attribute__((ext_vector_type(4)));
typedef float f32x2 __attribute__((ext_vector_type(2)));
typedef float f32x16 __attribute__((ext_vector_type(16)));
typedef unsigned u32x4 __attribute__((ext_vector_type(4)));
typedef unsigned u32x2 __attribute__((ext_vector_type(2)));

constexpr int NB = 4, SEQ = 4096, DM = 2048, DEPTH = 2, FF = 5632, NFF = 2 * FF;
constexpr int MT = NB * SEQ;
constexpr int SGW = 1024, NHEAD = 8, HD = 128, TOPK = 256;
constexpr int INCOLS = 6224;
constexpr int LDZ = 10496;
constexpr int ZU = 0, ZV = 1024, ZQ = 2048, ZK = 3072, ZVV = 4096, ZQI = 5120, ZKI = 6144, ZWI = 6208, ZG = 6400;
constexpr float NORM_EPS = 1e-6f, LN_EPS = 1e-5f;
#ifndef F8_MASK
#define F8_MASK 0xE
#endif
__host__ __device__ constexpr bool f8_on(int l, int i) { return (F8_MASK >> (2 * l + i)) & 1; }
#ifndef I8_MASK
#define I8_MASK 0x3F
#endif
constexpr float I8_WCLIP = 0.0884f, I8_SWQ = 127.f / I8_WCLIP;
constexpr float F8_SG = 8.f, F8_SW = 4096.f;

constexpr size_t MiB = 1u << 20;
constexpr size_t WS_CTL = 0, CTL_BYTES = 1 * MiB;
constexpr size_t WS_WF1I = 1 * MiB;
constexpr size_t WS_WF1O = WS_WF1I + 44 * MiB;
constexpr size_t WS_WF2I = WS_WF1O + 22 * MiB;
constexpr size_t WS_WF2O = WS_WF2I + 44 * MiB;
constexpr size_t WS_WMIX = WS_WF2O + 22 * MiB;
constexpr size_t WS_WA = WS_WMIX + 41 * MiB;
constexpr size_t WS_WB = WS_WA + 4 * MiB;
constexpr size_t WS_WO = WS_WB + 4 * MiB;
constexpr size_t WS_H = WS_WO + 8 * MiB;
constexpr size_t WS_F = WS_H + 64 * MiB;
constexpr size_t WS_Z = WS_F + 64 * MiB;
constexpr size_t WS_YA = WS_Z + 328 * MiB;
constexpr size_t WS_YB = WS_YA + 32 * MiB;
constexpr size_t WS_MASK = WS_YB + 32 * MiB;
constexpr size_t WS_WSB = WS_MASK + 8 * MiB;
constexpr size_t WS_XB = WS_WSB + 1 * MiB;
constexpr size_t WS_RS = WS_XB + 64 * MiB;
constexpr size_t WS_END = WS_RS + 1 * MiB;
constexpr int CW_BAR = 4096;

constexpr int RING_BYTES = 131072, LDSCTL_OFF = RING_BYTES, MISC_OFF = LDSCTL_OFF + 320, LDS_BYTES = 147456;
constexpr int RSL_OFF = LDSCTL_OFF + 4096;
constexpr int NWAVES = 8;

#define LDS_WAIT() asm volatile("s_waitcnt lgkmcnt(0)" ::: "memory")
#define VM_WAIT() asm volatile("s_waitcnt vmcnt(0)" ::: "memory")

typedef __bf16 bf16x2_t __attribute__((ext_vector_type(2)));
__device__ __forceinline__ unsigned cvt_pk_bf16(float lo, float hi) { f32x2 v = {lo, hi}; bf16x2_t r = __builtin_convertvector(v, bf16x2_t); return __builtin_bit_cast(unsigned, r); }
__device__ __forceinline__ float bf_lo(unsigned w) { return __uint_as_float(w << 16); }
__device__ __forceinline__ float bf_hi(unsigned w) { return __uint_as_float(w & 0xffff0000u); }
__device__ __forceinline__ float sigmoidf_(float x) { return __builtin_amdgcn_rcpf(1.0f + __builtin_amdgcn_exp2f(-1.4426950408889634f * x)); }
__device__ __forceinline__ float siluf_(float x) { return x * sigmoidf_(x); }
__device__ __forceinline__ float gelu_tanhf_(float x) { return x * sigmoidf_(1.5957691216057308f * (x + 0.044715f * x * x * x)); }
__device__ __forceinline__ float shx_f(float v, int o, int lane) { return __int_as_float(__builtin_amdgcn_ds_bpermute((lane ^ o) << 2, __float_as_int(v))); }
__device__ __forceinline__ unsigned shx_u(unsigned v, int o, int lane) { return (unsigned)__builtin_amdgcn_ds_bpermute((lane ^ o) << 2, (int)v); }
#define WR_DPP(v, ctl) __int_as_float(__builtin_amdgcn_update_dpp(0, __float_as_int(v), ctl, 0xF, 0xF, true))
__device__ __forceinline__ float wave_sum(float v, int) {
    v += WR_DPP(v, 0xB1); v += WR_DPP(v, 0x4E); v += WR_DPP(v, 0x141); v += WR_DPP(v, 0x140);
    { auto r = __builtin_amdgcn_permlane16_swap(__float_as_uint(v), __float_as_uint(v), false, false); v = __uint_as_float(r[0]) + __uint_as_float(r[1]); }
    { auto r = __builtin_amdgcn_permlane32_swap(__float_as_uint(v), __float_as_uint(v), false, false); v = __uint_as_float(r[0]) + __uint_as_float(r[1]); }
    return v;
}
__device__ __forceinline__ float wave_max(float v) {
    v = fmaxf(v, WR_DPP(v, 0xB1)); v = fmaxf(v, WR_DPP(v, 0x4E)); v = fmaxf(v, WR_DPP(v, 0x141)); v = fmaxf(v, WR_DPP(v, 0x140));
    { auto r = __builtin_amdgcn_permlane16_swap(__float_as_uint(v), __float_as_uint(v), false, false); v = fmaxf(__uint_as_float(r[0]), __uint_as_float(r[1])); }
    { auto r = __builtin_amdgcn_permlane32_swap(__float_as_uint(v), __float_as_uint(v), false, false); v = fmaxf(__uint_as_float(r[0]), __uint_as_float(r[1])); }
    return v;
}
#undef WR_DPP

namespace pg8 {
constexpr int BM = 256, BK = 64, HALF = 128, HTB = HALF * BK * 2, STAGE_BYTES = 8 * HTB, NXCD = 8, WGM = 8;
__host__ __device__ __forceinline__ int lds_byte(int r, int c) { const int st = (r >> 4) * 2 + (c >> 5), rr = r & 15, cc = c & 31, ob = rr * 64 + cc * 2; return st * 1024 + (ob ^ (((ob >> 9) & 1) << 5)); }
__host__ __device__ __forceinline__ void stage_rc(int b, int& R, int& C) { const int st = b / 1024, sb = b % 1024, swz = sb ^ (((sb >> 9) & 1) << 5); R = (st >> 1) * 16 + swz / 64; C = (st & 1) * 32 + (swz % 64) / 2; }
__host__ __device__ __forceinline__ int perm32(int rho) { const int n = rho >> 4, i = rho & 15; return 8 * (i >> 2) + 4 * n + (i & 3); }
struct Unit { int pm, pn; };
struct Gemm { const bf16_t* A; const bf16_t* Bt; int M, N, K; };
struct StaticOrder {
    int nM, nN, nwg, G, c;
    __host__ __device__ void init(int M, int N, int G_, int c_) { nM = M / BM; nN = N / BM; nwg = nM * nN; G = G_; c = c_; }
    __host__ __device__ bool next(int i, Unit& u) const {
        const long L = (long)i * G + c; if (L >= nwg) return false;
        int wgid = (int)L; { const int q = nwg / NXCD, r = nwg % NXCD, xcd = wgid % NXCD, off = wgid / NXCD; wgid = (xcd < r ? xcd * (q + 1) : r * (q + 1) + (xcd - r) * q) + off; }
        const int nig = WGM * nN, gid = wgid / nig, fm = gid * WGM, gsz = (nM - fm) < WGM ? (nM - fm) : WGM;
        u.pm = fm + ((wgid % nig) % gsz); u.pn = (wgid % nig) / gsz; return true;
    }
    __device__ __forceinline__ void a_ready(const Unit&) const {}
    __device__ __forceinline__ void done(const Unit&) const {}
};

template <int MODE, bool IACC = false> struct Epi {
    static __device__ __forceinline__ f32x4 ld(const f32x4& a) { if constexpr (IACC) { return (f32x4){(float)__float_as_int(a[0]), (float)__float_as_int(a[1]), (float)__float_as_int(a[2]), (float)__float_as_int(a[3])}; } else { return a; } }
    static constexpr bool PERM = true, AFTER_DRAIN = false;
    bf16_t* O; int ldc; const bf16_t* G; int ldg; const float* rs; float sc; float dq;
    struct Pre { float rsv[2][4]; };
    static constexpr bool USES_RS = (MODE == 1 || MODE == 2 || MODE == 5);
    __device__ __forceinline__ void prefetch(Pre& P, const LAS float* rsl, int wr, int fr) const {
        if constexpr (USES_RS) {
#pragma unroll
            for (int ai = 0; ai < 2; ++ai)
#pragma unroll
                for (int m = 0; m < 4; ++m) P.rsv[ai][m] = rsl[ai * HALF + wr * 64 + m * 16 + fr];
        }
    }
    template <int ACT> __device__ __forceinline__ void store_mix(const f32x4 (&acc)[2][2][4][2], const Pre& P, int row0, int col0, int kvh = -1, float osc = 1.f) const {
        constexpr float C0 = -1.5957691216057308f * 1.4426950408889634f, C1 = 0.044715f * C0;
#pragma unroll
        for (int ai = 0; ai < 2; ++ai)
#pragma unroll
            for (int m = 0; m < 4; ++m) {
                const size_t row = (size_t)(row0 + ai * HALF + m * 16);
                const float rsv = P.rsv[ai][m] * dq * osc, k2 = rsv * -1.4426950408889634f;
#pragma unroll
                for (int bj = 0; bj < 2; ++bj) {
                    f32x4 v0 = ld(acc[ai][bj][m][0]), v1 = ld(acc[ai][bj][m][1]);
                    if constexpr (ACT == 2) {
#pragma unroll
                        for (int j = 0; j < 4; ++j) { v0[j] = __builtin_amdgcn_rcpf(1.0f + __builtin_amdgcn_exp2f(v0[j] * k2)); v1[j] = __builtin_amdgcn_rcpf(1.0f + __builtin_amdgcn_exp2f(v1[j] * k2)); }
                    } else {
                        v0 = v0 * rsv; v1 = v1 * rsv;
                        if constexpr (ACT == 1) {
#pragma unroll
                            for (int j = 0; j < 4; ++j) {
                                { const float x = v0[j]; v0[j] = x * __builtin_amdgcn_rcpf(1.0f + __builtin_amdgcn_exp2f(x * fmaf(x * x, C1, C0))); }
                                { const float x = v1[j]; v1[j] = x * __builtin_amdgcn_rcpf(1.0f + __builtin_amdgcn_exp2f(x * fmaf(x * x, C1, C0))); } }
                        }
                    }
                    u32x4 w; w.x = cvt_pk_bf16(v0[0], v0[1]); w.y = cvt_pk_bf16(v0[2], v0[3]); w.z = cvt_pk_bf16(v1[0], v1[1]); w.w = cvt_pk_bf16(v1[2], v1[3]);
                    if (ACT == 0 && kvh >= 0) {
                        const size_t b_ = row >> 12, t_ = row & 4095;
                        *(u32x4*)(const_cast<bf16_t*>(G) + (((size_t)(kvh >> 3) * NB + b_) * NHEAD + (size_t)((kvh & 7) + bj)) * ((size_t)SEQ * 128) + t_ * 128 + (col0 & 127)) = w;
                    } else *(u32x4*)(O + row * ldc + col0 + bj * HALF) = w;
                }
            }
    }
    __device__ __forceinline__ void operator()(const f32x4 (&acc)[2][2][4][2], const Unit& u, int wr, int wc, int fr, int fq, const Pre& P) const {
        const int row0 = u.pm * BM + wr * 64 + fr;
        if constexpr (MODE == 5) {
            const int col0 = u.pn * HALF + wc * 32 + 8 * fq;
            unsigned char* Ob = (unsigned char*)O;
#pragma unroll
            for (int ai = 0; ai < 2; ++ai)
#pragma unroll
                for (int m = 0; m < 4; ++m) {
                    const float rsv = P.rsv[ai][m] * dq, k2 = rsv * -1.4426950408889634f, c2 = rsv * rsv * sc;
                    const f32x4 a0 = ld(acc[ai][0][m][0]), a1 = ld(acc[ai][0][m][1]), b0 = ld(acc[ai][1][m][0]), b1 = ld(acc[ai][1][m][1]);
                    float v[8];
#pragma unroll
                    for (int j = 0; j < 4; ++j) {
                        v[j] = (a0[j] * b0[j]) * (c2 * __builtin_amdgcn_rcpf(1.0f + __builtin_amdgcn_exp2f(a0[j] * k2)));
                        v[4 + j] = (a1[j] * b1[j]) * (c2 * __builtin_amdgcn_rcpf(1.0f + __builtin_amdgcn_exp2f(a1[j] * k2))); }
#pragma unroll
                    for (int j = 0; j < 8; ++j) v[j] = __builtin_amdgcn_fmed3f(v[j], -448.f, 448.f);
                    int w0 = 0, w1 = 0;
                    w0 = __builtin_amdgcn_cvt_pk_fp8_f32(v[0], v[1], w0, false); w0 = __builtin_amdgcn_cvt_pk_fp8_f32(v[2], v[3], w0, true);
                    w1 = __builtin_amdgcn_cvt_pk_fp8_f32(v[4], v[5], w1, false); w1 = __builtin_amdgcn_cvt_pk_fp8_f32(v[6], v[7], w1, true);
                    *(u32x2*)(Ob + (size_t)(row0 + ai * HALF + m * 16) * ldc + col0) = (u32x2){(unsigned)w0, (unsigned)w1};
                }
        } else if constexpr (MODE == 1) {
            const int col0 = u.pn * HALF + wc * 32 + 8 * fq;
#pragma unroll
            for (int ai = 0; ai < 2; ++ai)
#pragma unroll
                for (int m = 0; m < 4; ++m) {
                    bf16_t* rowp = O + (size_t)(row0 + ai * HALF + m * 16) * ldc + col0;
                    const float rsv = P.rsv[ai][m] * dq, k2 = rsv * -1.4426950408889634f, c2 = rsv * rsv;
                    const f32x4 a0 = ld(acc[ai][0][m][0]), a1 = ld(acc[ai][0][m][1]), b0 = ld(acc[ai][1][m][0]), b1 = ld(acc[ai][1][m][1]);
                    float v[8];
#pragma unroll
                    for (int j = 0; j < 4; ++j) {
                        v[j] = (a0[j] * b0[j]) * (c2 * __builtin_amdgcn_rcpf(1.0f + __builtin_amdgcn_exp2f(a0[j] * k2)));
                        v[4 + j] = (a1[j] * b1[j]) * (c2 * __builtin_amdgcn_rcpf(1.0f + __builtin_amdgcn_exp2f(a1[j] * k2))); }
                    u32x4 w;
                    w.x = cvt_pk_bf16(v[0], v[1]); w.y = cvt_pk_bf16(v[2], v[3]); w.z = cvt_pk_bf16(v[4], v[5]); w.w = cvt_pk_bf16(v[6], v[7]);
                    *(u32x4*)rowp = w;
                }
        } else {
            const int col0 = u.pn * BM + wc * 32 + 8 * fq;
            if constexpr (MODE == 2) { if (u.pn < 8) store_mix<1>(acc, P, row0, col0); else if (u.pn >= 25) store_mix<2>(acc, P, row0, col0); else store_mix<0>(acc, P, row0, col0, (G != nullptr && u.pn >= 12 && u.pn < 20) ? 2 * (u.pn - 12) : -1, (u.pn >= 8 && u.pn < 12) ? 0.12751743f : 1.f); return; }
#pragma unroll
            for (int ai = 0; ai < 2; ++ai) {
                u32x4 gv[4][2], ov[4][2];
                if constexpr (MODE == 3 || MODE == 4) {
#pragma unroll
                    for (int m = 0; m < 4; ++m)
#pragma unroll
                        for (int bj = 0; bj < 2; ++bj) { const size_t row = (size_t)(row0 + ai * HALF + m * 16);
                            gv[m][bj] = *(const u32x4*)(G + row * ldg + col0 + bj * HALF);
                            if constexpr (MODE == 4) ov[m][bj] = *(const u32x4*)(O + row * ldc + col0 + bj * HALF); }
                }
#pragma unroll
                for (int m = 0; m < 4; ++m) {
                    const size_t row = (size_t)(row0 + ai * HALF + m * 16);
#pragma unroll
                    for (int bj = 0; bj < 2; ++bj) {
                        f32x4 v0 = ld(acc[ai][bj][m][0]), v1 = ld(acc[ai][bj][m][1]);
                        bf16_t* op = O + row * ldc + col0 + bj * HALF;
                        if constexpr (MODE == 0) { v0 = v0 * sc; v1 = v1 * sc; }
                        if constexpr (MODE == 3 || MODE == 4) {
                            const u32x4 g = gv[m][bj];
                            v0[0] *= bf_lo(g.x); v0[1] *= bf_hi(g.x); v0[2] *= bf_lo(g.y); v0[3] *= bf_hi(g.y);
                            v1[0] *= bf_lo(g.z); v1[1] *= bf_hi(g.z); v1[2] *= bf_lo(g.w); v1[3] *= bf_hi(g.w);
                        }
                        if constexpr (MODE == 4) {
                            const u32x4 o = ov[m][bj];
                            v0[0] += bf_lo(o.x); v0[1] += bf_hi(o.x); v0[2] += bf_lo(o.y); v0[3] += bf_hi(o.y);
                            v1[0] += bf_lo(o.z); v1[1] += bf_hi(o.z); v1[2] += bf_lo(o.w); v1[3] += bf_hi(o.w);
                        }
                        u32x4 w; w.x = cvt_pk_bf16(v0[0], v0[1]); w.y = cvt_pk_bf16(v0[2], v0[3]); w.z = cvt_pk_bf16(v1[0], v1[1]); w.w = cvt_pk_bf16(v1[2], v1[3]);
                        *(u32x4*)op = w;
                    }
                }
            }
        }
    }
};

typedef int i32x4 __attribute__((ext_vector_type(4)));
typedef int i32x8 __attribute__((ext_vector_type(8)));
__device__ __forceinline__ i32x8 cat8(bf16x8 lo, bf16x8 hi) { const i32x4 a = __builtin_bit_cast(i32x4, lo), b = __builtin_bit_cast(i32x4, hi); return __builtin_shufflevector(a, b, 0, 1, 2, 3, 4, 5, 6, 7); }
template <class EpiT, class Sched, bool ALIGN_EPI = false, bool SP2 = false, int OPK = 0>
__device__ __forceinline__ void gemm_phase(LAS unsigned char* lds, const Gemm g, const Sched& S, const EpiT& E, const int tid) {
    const int wid = __builtin_amdgcn_readfirstlane(tid >> 6), lane = tid & 63, wr = wid >> 2, wc = wid & 3, fr = lane & 15, fq = lane >> 4;
    constexpr bool F8 = OPK == 1, I8 = OPK == 2;
    const int K = g.K, RB = (F8 || I8) ? K : 2 * K, nt = RB / (BK * 2);
    unsigned voffA[2], voffB[2];
#pragma unroll
    for (int i = 0; i < 2; ++i) { int R, C; stage_rc(tid * 16 + i * 8192, R, C); const int Rb = EpiT::PERM ? ((R & ~31) + perm32(R & 31)) : R;
        voffA[i] = (unsigned)(R * RB + C * 2); voffB[i] = (unsigned)(Rb * RB + C * 2); }
    const size_t kstep = (size_t)(BK * 2);
    const size_t hstep = (size_t)HALF * RB;
    const size_t tstep = 2 * hstep;
    const unsigned ldsw = (unsigned)wid * 1024u;
    const int aoff = lds_byte(wr * 64 + fr, fq * 8), boff = lds_byte(wc * 32 + fr, fq * 8);
#define PG8_SA(b, h) (((b) * 2 + (h)) * HTB)
#define PG8_SB(b, h) ((4 + (b) * 2 + (h)) * HTB)
#define PG8_STAGE(bufoff, gbase, voff) do { _Pragma("unroll") for (int _i = 0; _i < 2; ++_i) \
        __builtin_amdgcn_global_load_lds((const unsigned*)((const char*)(gbase) + (voff)[_i]), (LAS unsigned*)(lds + (bufoff) + ldsw + _i * 8192), 16, 0, 0); } while (0)
#define PG8_LDA(dst, b, h) do { _Pragma("unroll") for (int m = 0; m < 4; ++m) _Pragma("unroll") for (int k = 0; k < 2; ++k) dst[m][k] = *(const LAS bf16x8*)(lds + PG8_SA(b, h) + aoff + m * 2048 + k * 1024); } while (0)
#define PG8_LDB(dst, b, h) do { _Pragma("unroll") for (int n = 0; n < 2; ++n) _Pragma("unroll") for (int k = 0; k < 2; ++k) dst[n][k] = *(const LAS bf16x8*)(lds + PG8_SB(b, h) + boff + n * 2048 + k * 1024); } while (0)
#define PG8_MMA(ai, bj, At, Bt, Z) do { __builtin_amdgcn_s_setprio(1); _Pragma("unroll") for (int m = 0; m < 4; ++m) _Pragma("unroll") for (int n = 0; n < 2; ++n) { \
        if constexpr (F8) { const i32x8 b8_ = cat8(Bt[n][0], Bt[n][1]), a8_ = cat8(At[m][0], At[m][1]); \
            if constexpr (Z) asm volatile("v_mfma_f32_16x16x128_f8f6f4 %0, %1, %2, 0" : "=&v"(acc[ai][bj][m][n]) : "v"(b8_), "v"(a8_)); \
            else asm volatile("v_mfma_f32_16x16x128_f8f6f4 %0, %1, %2, %0" : "+v"(acc[ai][bj][m][n]) : "v"(b8_), "v"(a8_)); }     \
        else if constexpr (I8) { const i32x4 b40_ = __builtin_bit_cast(i32x4, Bt[n][0]), a40_ = __builtin_bit_cast(i32x4, At[m][0]), b41_ = __builtin_bit_cast(i32x4, Bt[n][1]), a41_ = __builtin_bit_cast(i32x4, At[m][1]); \
            if constexpr (Z) asm volatile("v_mfma_i32_16x16x64_i8 %0, %1, %2, 0" : "=&v"(acc[ai][bj][m][n]) : "v"(b40_), "v"(a40_)); \
            else asm volatile("v_mfma_i32_16x16x64_i8 %0, %1, %2, %0" : "+v"(acc[ai][bj][m][n]) : "v"(b40_), "v"(a40_)); \
            asm volatile("v_mfma_i32_16x16x64_i8 %0, %1, %2, %0" : "+v"(acc[ai][bj][m][n]) : "v"(b41_), "v"(a41_)); }     \
        else { acc[ai][bj][m][n] = __builtin_amdgcn_mfma_f32_16x16x32_bf16(Bt[n][0], At[m][0], acc[ai][bj][m][n], 0, 0, 0);     \
            acc[ai][bj][m][n] = __builtin_amdgcn_mfma_f32_16x16x32_bf16(Bt[n][1], At[m][1], acc[ai][bj][m][n], 0, 0, 0); } } \
        __builtin_amdgcn_s_setprio(0); } while (0)
#define PG8_WAIT_V(n) asm volatile("s_waitcnt vmcnt(" #n ")" ::: "memory")
#define PG8_WAIT_L(n) asm volatile("s_waitcnt lgkmcnt(" #n ")" ::: "memory")
#define PG8_BAR __builtin_amdgcn_s_barrier()
#define PG8_SCHED __builtin_amdgcn_sched_barrier(0)
    Unit cur, nxt; int ui = 0;
    if (!S.next(0, cur)) return;
    f32x4 acc[2][2][4][2];
#define PG8_ZERO() do { if constexpr (!(F8 || I8)) { _Pragma("unroll") for (int a = 0; a < 2; ++a) _Pragma("unroll") for (int b = 0; b < 2; ++b) _Pragma("unroll") for (int m = 0; m < 4; ++m) _Pragma("unroll") for (int n = 0; n < 2; ++n) acc[a][b][m][n] = (f32x4){0.f, 0.f, 0.f, 0.f}; } } while (0)
    PG8_ZERO();
    bf16x8 At[4][2], B0[2][2], B1[2][2];
    const char* cA = (const char*)g.A + (size_t)cur.pm * tstep; const char* cB = (const char*)g.Bt + (size_t)cur.pn * tstep;
    S.a_ready(cur);
    if constexpr (SP2) {
        PG8_STAGE(PG8_SB(0, 0), cB, voffB); PG8_STAGE(PG8_SB(0, 1), cB + hstep, voffB); PG8_STAGE(PG8_SA(0, 0), cA, voffA); PG8_STAGE(PG8_SA(0, 1), cA + hstep, voffA);
        if (wr == 1) PG8_BAR;
        PG8_WAIT_V(2); PG8_BAR;
        PG8_STAGE(PG8_SB(1, 0), cB + kstep, voffB); PG8_STAGE(PG8_SA(1, 0), cA + kstep, voffA); PG8_STAGE(PG8_SB(1, 1), cB + hstep + kstep, voffB);
        PG8_WAIT_V(6); PG8_BAR;
    } else {
        PG8_STAGE(PG8_SB(0, 0), cB, voffB); PG8_STAGE(PG8_SA(0, 0), cA, voffA); PG8_STAGE(PG8_SB(0, 1), cB + hstep, voffB); PG8_STAGE(PG8_SA(0, 1), cA + hstep, voffA);
        if (wr == 1) PG8_BAR;
        PG8_WAIT_V(4); PG8_BAR;
        PG8_STAGE(PG8_SB(1, 0), cB + kstep, voffB); PG8_STAGE(PG8_SA(1, 0), cA + kstep, voffA); PG8_STAGE(PG8_SB(1, 1), cB + hstep + kstep, voffB);
        PG8_WAIT_V(6); PG8_BAR;
    }
    for (;;) {
        const bool has_next = S.next(ui + 1, nxt);
        const char* nA = has_next ? (const char*)g.A + (size_t)nxt.pm * tstep : cA; const char* nB = has_next ? (const char*)g.Bt + (size_t)nxt.pn * tstep : cB;
        static_assert(SP2, "only the two-superphase K-loop is kept");
#define PG8_ITER(Z) do {                                                                                                                           \
            const bool last = (t == nt - 2);                                                                                                        \
            const char* a1 = cA + (size_t)(t + 1) * kstep;                                                                                          \
            const char* a2 = last ? nA : cA + (size_t)(t + 2) * kstep; const char* b2 = last ? nB : cB + (size_t)(t + 2) * kstep;                    \
            const char* a3 = a2 + kstep; const char* b3 = b2 + kstep;                                                                               \
            if (last && has_next) S.a_ready(nxt);                                                                                                   \
            if constexpr (EpiT::USES_RS) { if (last && wid < 4) { int tl_ = tid; asm volatile("" : "+v"(tl_));     \
                __builtin_amdgcn_global_load_lds((const unsigned*)(E.rs + (size_t)cur.pm * BM + wid * 64 + (tl_ & 63)), (LAS unsigned*)(lds + RSL_OFF + wid * 256), 4, 0, 0); } }   \
            PG8_LDB(B0, 0, 0); PG8_LDB(B1, 0, 1); PG8_SCHED; PG8_LDA(At, 0, 0); PG8_STAGE(PG8_SA(1, 1), a1 + hstep, voffA);                          \
            PG8_WAIT_V(8); PG8_WAIT_L(0); PG8_BAR; PG8_MMA(0, 0, At, B0, Z); PG8_MMA(0, 1, At, B1, Z); PG8_BAR; PG8_SCHED;                          \
            PG8_LDA(At, 0, 1); PG8_STAGE(PG8_SB(0, 0), b2, voffB); PG8_STAGE(PG8_SB(0, 1), b2 + hstep, voffB); PG8_STAGE(PG8_SA(0, 0), a2, voffA);   \
            PG8_WAIT_V(8); PG8_WAIT_L(0); PG8_BAR; PG8_MMA(1, 0, At, B0, Z); PG8_MMA(1, 1, At, B1, Z); PG8_BAR; PG8_SCHED;                          \
            PG8_LDB(B0, 1, 0); PG8_LDB(B1, 1, 1); PG8_SCHED; PG8_LDA(At, 1, 0); PG8_STAGE(PG8_SA(0, 1), a2 + hstep, voffA);                          \
            PG8_WAIT_V(8); PG8_WAIT_L(0); PG8_BAR; PG8_MMA(0, 0, At, B0, false); PG8_MMA(0, 1, At, B1, false); PG8_BAR; PG8_SCHED;                  \
            PG8_LDA(At, 1, 1); PG8_STAGE(PG8_SB(1, 0), b3, voffB); PG8_STAGE(PG8_SB(1, 1), b3 + hstep, voffB); PG8_STAGE(PG8_SA(1, 0), a3, voffA);   \
            PG8_WAIT_V(8); PG8_WAIT_L(0); PG8_BAR; PG8_MMA(1, 0, At, B0, false); PG8_MMA(1, 1, At, B1, false); PG8_BAR; PG8_SCHED; } while (0)
        if constexpr (F8 || I8) { int t = 0; PG8_ITER(true);
          for (t = 2; t < nt; t += 2) PG8_ITER(false); }
        else { for (int t = 0; t < nt; t += 2) PG8_ITER(false); }
#undef PG8_ITER
        int tz2 = tid; asm volatile("" : "+v"(tz2));
        const int lane2 = tz2 & 63, fr2 = lane2 & 15, fq2 = lane2 >> 4;
        typename EpiT::Pre pre; E.prefetch(pre, (const LAS float*)(lds + RSL_OFF), wr, fr2);
        if constexpr (ALIGN_EPI) { if (wr == 0) PG8_BAR; }
        if constexpr (F8 || I8) asm volatile("s_nop 15\n\ts_nop 15" ::: "memory");
        E(acc, cur, wr, wc, fr2, fq2, pre); S.done(cur);
        if (!has_next) break;
        PG8_ZERO();
        cur = nxt; cA = nA; cB = nB; ++ui;
        if constexpr (ALIGN_EPI) { if (wr == 1) PG8_BAR; }
    }
    PG8_WAIT_V(0);
    if constexpr (!ALIGN_EPI) { if (wr == 0) PG8_BAR; }
    PG8_BAR;
#undef PG8_SA
#undef PG8_SB
#undef PG8_STAGE
#undef PG8_LDA
#undef PG8_LDB
#undef PG8_MMA
#undef PG8_WAIT_V
#undef PG8_WAIT_L
#undef PG8_BAR
#undef PG8_SCHED
}
}

#define XB_TMO      128
#define XB_XCNT(j)  (256  + 64 * (j))
#define XB_XSUB(j)  (1280 + 64 * (j))
#define XB_XGEN(j)  (2304 + 64 * (j))
#define XB_TOP      3328
#define XB_TOPGEN   3392
#define XCD_BAR_WORDS 3456
#define XB_SPIN_CAP (1u << 18)
__device__ __forceinline__ unsigned xb_ld(unsigned* p)              { return __hip_atomic_load(p, __ATOMIC_RELAXED, __HIP_MEMORY_SCOPE_AGENT); }
__device__ __forceinline__ unsigned xb_add(unsigned* p, unsigned v) { return __hip_atomic_fetch_add(p, v, __ATOMIC_RELAXED, __HIP_MEMORY_SCOPE_AGENT); }
__device__ __forceinline__ unsigned xb_xcc_id() { return (unsigned)__builtin_amdgcn_s_getreg((3 << 11) | 20) & 0xFu; }
#define XB_SPIN(cond, bar) do { unsigned _sp = 0; while (cond) { __builtin_amdgcn_s_sleep(1); \
    if ((++_sp & 255u) == 0u) { if (xb_ld(&(bar)[XB_TMO])) break; if (_sp > XB_SPIN_CAP) { atomicAdd(&(bar)[XB_TMO], 1u); break; } } } } while (0)
struct XcdBarrier { unsigned* bar; unsigned x; volatile LAS unsigned* st; };
__device__ __forceinline__ XcdBarrier xcd_barrier_post(unsigned* bar, volatile LAS unsigned* st, const int tid) {
    XcdBarrier b; b.bar = bar; b.x = xb_xcc_id(); b.st = st;
    if (tid == 0) (void)xb_add(&bar[XB_XCNT(b.x)], 1u);
    return b;
}
__device__ __forceinline__ void xcd_barrier_complete(unsigned* bar, unsigned x, unsigned& nloc, unsigned& nx) {
    const unsigned G = gridDim.x * gridDim.y * gridDim.z;
    unsigned sum, cnt, mine, sp = 0u;
    for (;;) {
        sum = 0u; cnt = 0u; mine = 0u;
#pragma unroll
        for (unsigned j = 0; j < 16; ++j) { const unsigned c = xb_ld(&bar[XB_XCNT(j)]); sum += c; cnt += (c > 0u) ? 1u : 0u; mine = (j == x) ? c : mine; }
        if (sum == G) break;
        __builtin_amdgcn_s_sleep(1);
        if ((++sp & 255u) == 0u) { if (xb_ld(&bar[XB_TMO])) break; if (sp > XB_SPIN_CAP) { atomicAdd(&bar[XB_TMO], 1u); break; } }
    }
    nloc = mine > 0u ? mine : 1u; nx = cnt > 0u ? cnt : 1u;
}
__device__ __forceinline__ void xcd_barrier(const XcdBarrier& b, const int tid) {
    asm volatile("s_waitcnt vmcnt(0)" ::: "memory");
    __syncthreads();
    if (tid == 0) {
        unsigned* bar = b.bar;
        __builtin_amdgcn_s_waitcnt(0);
        unsigned nloc = b.st[0], nx = b.st[1];
        if (nloc == 0u) { xcd_barrier_complete(bar, b.x, nloc, nx); b.st[0] = nloc; b.st[1] = nx; }
        const unsigned old = xb_add(&bar[XB_XSUB(b.x)], 1u);
        const unsigned gen = old / nloc;
        if (old + 1u == (gen + 1u) * nloc) {
            __builtin_amdgcn_fence(__ATOMIC_RELEASE, "agent");
            asm volatile("s_waitcnt vmcnt(0)" ::: "memory");
            const unsigned og = xb_add(&bar[XB_TOP], 1u);
            const unsigned tg = og / nx;
            if (og + 1u == (tg + 1u) * nx) xb_add(&bar[XB_TOPGEN], 1u);
            else XB_SPIN(xb_ld(&bar[XB_TOPGEN]) == tg, bar);
            __builtin_amdgcn_fence(__ATOMIC_ACQUIRE, "agent");
            xb_add(&bar[XB_XGEN(b.x)], 1u);
            asm volatile("s_waitcnt vmcnt(0)" ::: "memory");
        } else {
            XB_SPIN(xb_ld(&bar[XB_XGEN(b.x)]) == gen, bar);
            __builtin_amdgcn_fence(__ATOMIC_ACQUIRE, "agent");
            asm volatile("s_waitcnt vmcnt(0)" ::: "memory");
        }
    }
    __syncthreads();
}

struct Args {
    const float* in[21]; float* out; unsigned char* ws; int ph_lo, ph_hi;
};
struct Frame {
    LAS unsigned char* lds;
    int wave, vcu, G;
};
__device__ __forceinline__ int frame_tid(const Frame& F) { unsigned seed = 0u; asm volatile("" : "+s"(seed));
    return F.wave * 64 + (int)__builtin_amdgcn_mbcnt_hi(~0u, __builtin_amdgcn_mbcnt_lo(~0u, seed)); }

__device__ __forceinline__ void transpose_item(const float* W, int K, int N, int k0, int n0, int nvalid, bf16_t* WT, size_t drow0, LAS float* scr, int lane, const float* gain) {
    const int nl = lane & 31;
    float tv[32];
#pragma unroll
    for (int i = 0; i < 32; ++i) { const int kk = 2 * i + (lane >> 5); tv[i] = (nl < nvalid) ? __builtin_nontemporal_load(W + (size_t)(k0 + kk) * N + n0 + nl) : 0.f; }
#pragma unroll
    for (int i = 0; i < 32; ++i) { const int kk = 2 * i + (lane >> 5); scr[kk * 33 + nl] = tv[i]; }
    LDS_WAIT(); asm volatile("" ::: "memory");
    const int c = lane & 7;
    f32x4 g0 = {1.f, 1.f, 1.f, 1.f}, g1 = {1.f, 1.f, 1.f, 1.f};
    if (gain) { g0 = *(const f32x4*)(gain + k0 + 8 * c); g1 = *(const f32x4*)(gain + k0 + 8 * c + 4); }
#pragma unroll
    for (int j = 0; j < 4; ++j) { const int n = (lane >> 3) + 8 * j; const LAS float* s = scr + (8 * c) * 33 + n;
        u32x4 o; o.x = cvt_pk_bf16(s[0 * 33] * g0[0], s[1 * 33] * g0[1]); o.y = cvt_pk_bf16(s[2 * 33] * g0[2], s[3 * 33] * g0[3]); o.z = cvt_pk_bf16(s[4 * 33] * g1[0], s[5 * 33] * g1[1]); o.w = cvt_pk_bf16(s[6 * 33] * g1[2], s[7 * 33] * g1[3]);
        *(u32x4*)(WT + (drow0 + n) * K + k0 + 8 * c) = o; }
    LDS_WAIT(); asm volatile("" ::: "memory");
}
__device__ __forceinline__ u32x2 pack8_b8(const float (&v)[8], bool i8) {
    if (i8) {
        unsigned w0 = 0u, w1 = 0u;
#pragma unroll
        for (int q = 0; q < 4; ++q) { w0 = __builtin_amdgcn_cvt_pk_u8_f32(fminf(fmaxf(v[q], -127.f), 127.f) + 128.f, q, w0); w1 = __builtin_amdgcn_cvt_pk_u8_f32(fminf(fmaxf(v[4 + q], -127.f), 127.f) + 128.f, q, w1); }
        return (u32x2){w0 ^ 0x80808080u, w1 ^ 0x80808080u};
    }
    float c[8];
#pragma unroll
    for (int q = 0; q < 8; ++q) c[q] = fminf(fmaxf(v[q], -448.f), 448.f);
    int w0 = 0, w1 = 0;
    w0 = __builtin_amdgcn_cvt_pk_fp8_f32(c[0], c[1], w0, false); w0 = __builtin_amdgcn_cvt_pk_fp8_f32(c[2], c[3], w0, true);
    w1 = __builtin_amdgcn_cvt_pk_fp8_f32(c[4], c[5], w1, false); w1 = __builtin_amdgcn_cvt_pk_fp8_f32(c[6], c[7], w1, true);
    return (u32x2){(unsigned)w0, (unsigned)w1};
}
__device__ __forceinline__ void transpose_item_b8(const float* W, int K, int N, int k0, int n0, int nvalid, unsigned char* WT8, size_t drow0, LAS float* scr, int lane, const float* gain, float scale, bool i8) {
    const int nl = lane & 31;
    float tv[32];
#pragma unroll
    for (int i = 0; i < 32; ++i) { const int kk = 2 * i + (lane >> 5); tv[i] = (nl < nvalid) ? __builtin_nontemporal_load(W + (size_t)(k0 + kk) * N + n0 + nl) : 0.f; }
#pragma unroll
    for (int i = 0; i < 32; ++i) { const int kk = 2 * i + (lane >> 5); scr[kk * 33 + nl] = tv[i]; }
    LDS_WAIT(); asm volatile("" ::: "memory");
    const int c = lane & 7;
    f32x4 g0 = {scale, scale, scale, scale}, g1 = g0;
    if (gain) { g0 = *(const f32x4*)(gain + k0 + 8 * c) * scale; g1 = *(const f32x4*)(gain + k0 + 8 * c + 4) * scale; }
#pragma unroll
    for (int j = 0; j < 4; ++j) { const int n = (lane >> 3) + 8 * j; const LAS float* s = scr + (8 * c) * 33 + n;
        float v[8];
#pragma unroll
        for (int q = 0; q < 8; ++q) v[q] = s[q * 33] * (q < 4 ? g0[q & 3] : g1[q & 3]);
        *(u32x2*)(WT8 + (drow0 + n) * K + k0 + 8 * c) = pack8_b8(v, i8); }
    LDS_WAIT(); asm volatile("" ::: "memory");
}
__device__ __forceinline__ void conv_swiglu_b8(const float* W, unsigned char* WT8, int item, LAS float* scr, int lane, const float* gain, float scale, bool i8) {
    const int nblk = NFF / 32, kb = item / nblk, nb = item % nblk, n0 = 32 * nb;
    const int isb = n0 >= FF, n1 = isb ? n0 - FF : n0;
    const size_t drow = (size_t)(n1 >> 7) * 256 + (isb ? 128 : 0) + (n1 & 127);
    transpose_item_b8(W, DM, NFF, 64 * kb, n0, 32, WT8, drow, scr, lane, gain, scale, i8);
}
__device__ __forceinline__ void conv_plain_b8(const float* W, int K, int N, unsigned char* WT8, size_t drow_off, int item, LAS float* scr, int lane, const float* gain, float scale, bool i8) {
    const int nblk = (N + 31) / 32, kb = item / nblk, nb = item % nblk, n0 = 32 * nb;
    const int nv = (N - n0) < 32 ? (N - n0) : 32;
    transpose_item_b8(W, K, N, 64 * kb, n0, nv, WT8, drow_off + n0, scr, lane, gain, scale, i8);
}
__device__ __forceinline__ void conv_plain(const float* W, int K, int N, bf16_t* WT, size_t drow_off, int item, LAS float* scr, int lane, const float* gain) {
    const int nblk = (N + 31) / 32, kb = item / nblk, nb = item % nblk, n0 = 32 * nb;
    const int nv = (N - n0) < 32 ? (N - n0) : 32;
    transpose_item(W, K, N, 64 * kb, n0, nv, WT, drow_off + n0, scr, lane, gain);
}
__device__ __forceinline__ void conv_swiglu(const float* W, bf16_t* WT, int item, LAS float* scr, int lane, const float* gain) {
    const int nblk = NFF / 32, kb = item / nblk, nb = item % nblk, n0 = 32 * nb;
    const int isb = n0 >= FF, n1 = isb ? n0 - FF : n0;
    const size_t drow = (size_t)(n1 >> 7) * 256 + (isb ? 128 : 0) + (n1 & 127);
    transpose_item(W, DM, NFF, 64 * kb, n0, 32, WT, drow, scr, lane, gain);
}

constexpr int CV_S1 = (DM / 64) * (NFF / 32) + (FF / 64) * (DM / 32), CV_S2 = 2 * CV_S1,
              CV_END = CV_S2 + (DM / 64) * ((INCOLS + 31) / 32) + (DM / 64) * (2 * DM / 32) + 2 * (SGW / 64) * (DM / 32) + (DM / 64) * (DM / 32) + ((ZG - 6240) * DM * 2) / 1024 + 8 * 128 * 128 / 512;
struct LayerW {
    const float *f1i, *f1o, *f2i, *f2o, *win, *wg, *wa, *wb, *wo, *wss, *g_f1, *g_f2, *g_mix; bool f8_1, f8_2, q8_1, q8_2, q8_m;
};
__device__ __forceinline__ void conv_phase(const Frame& F, const LayerW& L, unsigned char* ws, const int tz, int widx, int nworkers, int it_lo, int it_hi) {
    const int lane_ = tz & 63;
    LAS float* scr = (LAS float*)(F.lds + F.wave * 8704);
    const int gw = widx * NWAVES + F.wave, NGW = nworkers * NWAVES;
    constexpr int I_FI = (DM / 64) * (NFF / 32), I_FO = (FF / 64) * (DM / 32), I_WIN = (DM / 64) * ((INCOLS + 31) / 32), I_WG = (DM / 64) * (2 * DM / 32),
                  I_WA = (SGW / 64) * (DM / 32), I_WO = (DM / 64) * (DM / 32), I_ZERO = ((ZG - 6240) * DM * 2) / 1024, I_WSS = 8 * 128 * 128 / 512;
    constexpr int NITEMS = 2 * I_FI + 2 * I_FO + I_WIN + I_WG + 2 * I_WA + I_WO + I_ZERO + I_WSS;
    bf16_t* wf1i = (bf16_t*)(ws + WS_WF1I); bf16_t* wf1o = (bf16_t*)(ws + WS_WF1O); bf16_t* wf2i = (bf16_t*)(ws + WS_WF2I); bf16_t* wf2o = (bf16_t*)(ws + WS_WF2O);
    bf16_t* wmix = (bf16_t*)(ws + WS_WMIX); bf16_t* wa = (bf16_t*)(ws + WS_WA); bf16_t* wb = (bf16_t*)(ws + WS_WB); bf16_t* wo = (bf16_t*)(ws + WS_WO);
    (void)NITEMS;
    for (int it = it_lo + gw; it < it_hi; it += NGW) {
        int r = it;
        if (r < I_FI) { if (L.q8_1) conv_swiglu_b8(L.f1i, (unsigned char*)wf1i, r, scr, lane_, L.g_f1, I8_SWQ, true); else conv_swiglu(L.f1i, wf1i, r, scr, lane_, L.g_f1); continue; } r -= I_FI;
        if (r < I_FO) { if (L.f8_1) conv_plain_b8(L.f1o, FF, DM, (unsigned char*)wf1o, 0, r, scr, lane_, nullptr, F8_SW, false); else conv_plain(L.f1o, FF, DM, wf1o, 0, r, scr, lane_, nullptr); continue; } r -= I_FO;
        if (r < I_FI) { if (L.q8_2) conv_swiglu_b8(L.f2i, (unsigned char*)wf2i, r, scr, lane_, L.g_f2, I8_SWQ, true); else conv_swiglu(L.f2i, wf2i, r, scr, lane_, L.g_f2); continue; } r -= I_FI;
        if (r < I_FO) { if (L.f8_2) conv_plain_b8(L.f2o, FF, DM, (unsigned char*)wf2o, 0, r, scr, lane_, nullptr, F8_SW, false); else conv_plain(L.f2o, FF, DM, wf2o, 0, r, scr, lane_, nullptr); continue; } r -= I_FO;
        if (r < I_WIN) { if (L.q8_m) conv_plain_b8(L.win, DM, INCOLS, (unsigned char*)wmix, 0, r, scr, lane_, L.g_mix, I8_SWQ, true); else conv_plain(L.win, DM, INCOLS, wmix, 0, r, scr, lane_, L.g_mix); continue; } r -= I_WIN;
        if (r < I_WG) { if (L.q8_m) conv_plain_b8(L.wg, DM, 2 * DM, (unsigned char*)wmix, ZG, r, scr, lane_, L.g_mix, I8_SWQ, true); else conv_plain(L.wg, DM, 2 * DM, wmix, ZG, r, scr, lane_, L.g_mix); continue; } r -= I_WG;
        if (r < I_WA) { conv_plain(L.wa, SGW, DM, wa, 0, r, scr, lane_, nullptr); continue; } r -= I_WA;
        if (r < I_WA) { conv_plain(L.wb, SGW, DM, wb, 0, r, scr, lane_, nullptr); continue; } r -= I_WA;
        if (r < I_WO) { conv_plain(L.wo, DM, DM, wo, 0, r, scr, lane_, nullptr); continue; } r -= I_WO;
        if (r < I_ZERO) { unsigned z0 = 0u; asm volatile("" : "+v"(z0)); const size_t esz = L.q8_m ? 1 : 2;
            u32x4* z = (u32x4*)((unsigned char*)wmix + (size_t)6240 * DM * esz + ((size_t)r * 1024) % ((size_t)160 * DM * esz)) + lane_; *z = (u32x4){z0, z0, z0, z0}; continue; } r -= I_ZERO;
        {
            const int e0 = r * 512 + lane_ * 8, t = (e0 >> 7) & 127, s0 = e0 & 127;
            const f32x4 a = *(const f32x4*)(L.wss + e0), c = *(const f32x4*)(L.wss + e0 + 4);
            float v[8] = {a[0], a[1], a[2], a[3], c[0], c[1], c[2], c[3]};
#pragma unroll
            for (int j = 0; j < 8; ++j) v[j] = (s0 + j <= t) ? v[j] : 0.f;
            u32x4 o; o.x = cvt_pk_bf16(v[0], v[1]); o.y = cvt_pk_bf16(v[2], v[3]); o.z = cvt_pk_bf16(v[4], v[5]); o.w = cvt_pk_bf16(v[6], v[7]);
            *(u32x4*)((bf16_t*)(ws + WS_WSB) + e0) = o;
        }
    }
}

__device__ __forceinline__ void thin_phase(const Frame& F, const float* x_in, bf16_t* xb, const bf16_t* f, const float* gpost, float scale, float* rs, float* xf, unsigned char* xq, const int tz) {
    const int lane_ = tz & 63;
    const int gw = F.vcu * NWAVES + F.wave, NGW = F.G * NWAVES;
    f32x4 v[8]; u32x2 xw[8], nxw[8], fw[8], nfw[8]; f32x4 nv[8];
    int m = gw;
    if (m < MT) {
        if (x_in) { const f32x4* xr = (const f32x4*)(x_in + (size_t)m * DM) + lane_;
#pragma unroll
            for (int j = 0; j < 8; ++j) v[j] = __builtin_nontemporal_load(xr + 64 * j); }
        else { const u32x2* xr = (const u32x2*)(xb + (size_t)m * DM) + lane_;
#pragma unroll
            for (int j = 0; j < 8; ++j) xw[j] = __builtin_nontemporal_load(xr + 64 * j); }
        if (f) { const u32x2* fr = (const u32x2*)(f + (size_t)m * DM) + lane_;
#pragma unroll
            for (int j = 0; j < 8; ++j) fw[j] = __builtin_nontemporal_load(fr + 64 * j); }
    }
    f32x4 gq[8];
    if (f) { const f32x4* gp = (const f32x4*)gpost + lane_;
#pragma unroll
        for (int j = 0; j < 8; ++j) gq[j] = gp[64 * j]; }
    for (; m < MT; m += NGW) {
        const int mn_ = m + NGW;
        if (mn_ < MT) {
            if (x_in) { const f32x4* xr = (const f32x4*)(x_in + (size_t)mn_ * DM) + lane_;
#pragma unroll
                for (int j = 0; j < 8; ++j) nv[j] = __builtin_nontemporal_load(xr + 64 * j); }
            else { const u32x2* xr = (const u32x2*)(xb + (size_t)mn_ * DM) + lane_;
#pragma unroll
                for (int j = 0; j < 8; ++j) nxw[j] = __builtin_nontemporal_load(xr + 64 * j); }
            if (f) { const u32x2* fr = (const u32x2*)(f + (size_t)mn_ * DM) + lane_;
#pragma unroll
                for (int j = 0; j < 8; ++j) nfw[j] = __builtin_nontemporal_load(fr + 64 * j); }
        }
        if (!x_in) {
#pragma unroll
            for (int j = 0; j < 8; ++j) v[j] = (f32x4){bf_lo(xw[j].x), bf_hi(xw[j].x), bf_lo(xw[j].y), bf_hi(xw[j].y)};
        }
        if (f) {
            f32x4 fv[8]; float s = 0.f;
#pragma unroll
            for (int j = 0; j < 8; ++j) { const u32x2 w = fw[j]; fv[j] = (f32x4){bf_lo(w.x), bf_hi(w.x), bf_lo(w.y), bf_hi(w.y)}; s += (fv[j][0] * fv[j][0] + fv[j][1] * fv[j][1]) + (fv[j][2] * fv[j][2] + fv[j][3] * fv[j][3]); }
            const float r = scale * __builtin_amdgcn_rsqf(wave_sum(s, lane_) * (1.f / DM) + NORM_EPS);
#pragma unroll
            for (int j = 0; j < 8; ++j) v[j] = v[j] + fv[j] * gq[j] * r;
        }
        if (xf) {
            f32x4* xo = (f32x4*)(xf + (size_t)m * DM) + lane_;
#pragma unroll
            for (int j = 0; j < 8; ++j) __builtin_nontemporal_store(v[j], xo + 64 * j);
        } else {
            u32x2* xo = (u32x2*)(xb + (size_t)m * DM) + lane_;
            float s = 0.f;
#pragma unroll
            for (int j = 0; j < 8; ++j) { u32x2 w; w.x = cvt_pk_bf16(v[j][0], v[j][1]); w.y = cvt_pk_bf16(v[j][2], v[j][3]); __builtin_nontemporal_store(w, xo + 64 * j);
                s += (v[j][0] * v[j][0] + v[j][1] * v[j][1]) + (v[j][2] * v[j][2] + v[j][3] * v[j][3]); }
            const float r = __builtin_amdgcn_rsqf(wave_sum(s, lane_) * (1.f / DM) + NORM_EPS);
            if (lane_ == 0) rs[m] = r;
            if (xq) {
                float am = 0.f;
#pragma unroll
                for (int j = 0; j < 8; ++j) am = fmaxf(fmaxf(am, fmaxf(fabsf(v[j][0]), fabsf(v[j][1]))), fmaxf(fabsf(v[j][2]), fabsf(v[j][3])));
                am = wave_max(am);
                am = fmaxf(am, 1e-20f);
                const float qs = 127.f / am;
                unsigned* xqo = (unsigned*)(xq + (size_t)m * DM) + lane_;
#pragma unroll
                for (int j = 0; j < 8; ++j) { unsigned w8 = 0u;
#pragma unroll
                    for (int e = 0; e < 4; ++e) w8 = __builtin_amdgcn_cvt_pk_u8_f32(v[j][e] * qs + 128.f, e, w8);
                    xqo[64 * j] = w8 ^ 0x80808080u; }
                if (lane_ == 0) rs[MT + m] = r * am * (1.f / 127.f);
            }
        }
#pragma unroll
        for (int j = 0; j < 8; ++j) { v[j] = nv[j]; xw[j] = nxw[j]; fw[j] = nfw[j]; }
    }
}

constexpr int IDX_BUF = 256 * 128;
__device__ __forceinline__ void indexer_unit(LAS unsigned char* lds, const bf16_t* Z, unsigned* mask, int b, int tb, int wave, int tid) {
    asm volatile("" : "+v"(tid));
    const int lane = tid & 63, hi = lane >> 5, r32 = lane & 31;
    const int t0 = tb + 2 * wave, tq = t0 + hi;
    const int aq = t0 + ((r32 >> 2) & 1), ah = (r32 >> 3) * 4 + (r32 & 3);
    const bf16_t* ap = Z + (size_t)(b * SEQ + aq) * LDZ + ZQI + ah * 64 + hi * 8;
    bf16x8 af[4];
#pragma unroll
    for (int ks = 0; ks < 4; ++ks) af[ks] = *(const bf16x8*)(ap + 16 * ks);
    float wv[16];
    { const u32x4* wp = (const u32x4*)(Z + (size_t)(b * SEQ + tq) * LDZ + ZWI); const u32x4 w0 = wp[0], w1 = wp[1];
      const float sc = 0.125f * 0.25f;
      wv[0] = bf_lo(w0.x) * sc; wv[1] = bf_hi(w0.x) * sc; wv[2] = bf_lo(w0.y) * sc; wv[3] = bf_hi(w0.y) * sc; wv[4] = bf_lo(w0.z) * sc; wv[5] = bf_hi(w0.z) * sc; wv[6] = bf_lo(w0.w) * sc; wv[7] = bf_hi(w0.w) * sc;
      wv[8] = bf_lo(w1.x) * sc; wv[9] = bf_hi(w1.x) * sc; wv[10] = bf_lo(w1.y) * sc; wv[11] = bf_hi(w1.y) * sc; wv[12] = bf_lo(w1.z) * sc; wv[13] = bf_hi(w1.z) * sc; wv[14] = bf_lo(w1.w) * sc; wv[15] = bf_hi(w1.w) * sc; }
    const int nkt = (t0 + 1) / 32 + 1;
    const int nch = (tb + 15) / 256 + 1;
    const int srow = lane >> 3, spiece = (lane & 7) ^ (srow >> 1);
    const bf16_t* gkr = Z + (size_t)(b * SEQ + 32 * wave + srow) * LDZ + ZKI;
    const bf16_t* gk = gkr + spiece * 8; const bf16_t* gk4 = gkr + (spiece ^ 4) * 8;
    const unsigned rd0 = (unsigned)(r32 * 128), rsw = (unsigned)((r32 >> 1) & 7);
    unsigned rdo[4];
#pragma unroll
    for (int ks = 0; ks < 4; ++ks) rdo[ks] = rd0 + ((((unsigned)hi + 2u * ks) ^ rsw) << 4);
    __syncthreads();
#pragma unroll
    for (int i = 0; i < 4; ++i)
        __builtin_amdgcn_global_load_lds((const unsigned*)(((i & 1) ? gk4 : gk) + (size_t)(8 * i) * LDZ), (LAS unsigned*)(lds + wave * 4096 + i * 1024), 16, 0, 0);
    unsigned key[128];
#pragma unroll
    for (int c = 0; c < 16; ++c) {
#pragma unroll
        for (int k = 0; k < 8; ++k) key[c * 8 + k] = 0u;
        if (c < nch) {
            asm volatile("s_waitcnt vmcnt(0)" ::: "memory");
            __syncthreads();
            if (c + 1 < nch) {
#pragma unroll
                for (int i = 0; i < 4; ++i)
                    __builtin_amdgcn_global_load_lds((const unsigned*)(((i & 1) ? gk4 : gk) + (size_t)(256 * (c + 1) + 8 * i) * LDZ), (LAS unsigned*)(lds + ((c + 1) & 1) * IDX_BUF + wave * 4096 + i * 1024), 16, 0, 0);
            }
#pragma unroll
            for (int k = 0; k < 8; k += 2) {
                const int kt = c * 8 + k;
                const LAS unsigned char* bp = lds + (c & 1) * IDX_BUF + k * 4096;
                bf16x8 bfa[4], bfb[4];
#pragma unroll
                for (int ks = 0; ks < 4; ++ks) { bfa[ks] = *(const LAS bf16x8*)(bp + rdo[ks]); bfb[ks] = *(const LAS bf16x8*)(bp + 4096 + rdo[ks]); }
                f32x16 acca = {}, accb = {};
#pragma unroll
                for (int ks = 0; ks < 4; ++ks) { acca = __builtin_amdgcn_mfma_f32_32x32x16_bf16(af[ks], bfa[ks], acca, 0, 0, 0); accb = __builtin_amdgcn_mfma_f32_32x32x16_bf16(af[ks], bfb[ks], accb, 0, 0, 0); }
                {
                    f32x2 s2 = {0.f, 0.f};
#pragma unroll
                    for (int r = 0; r < 16; r += 2) { int r0 = __float_as_int(acca[r]), r1 = __float_as_int(acca[r + 1]); r0 = r0 > 0 ? r0 : 0; r1 = r1 > 0 ? r1 : 0;
                        s2 = __builtin_elementwise_fma((f32x2){__int_as_float(r0), __int_as_float(r1)}, (f32x2){wv[r], wv[r + 1]}, s2); }
                    float s = s2[0] + s2[1];
                    asm volatile("" : "+v"(s));
                    const unsigned u = __float_as_uint(s);
                    const unsigned kk = u ^ ((unsigned)((int)u >> 31) | 0x80000000u);
                    key[kt] = (32 * kt + r32 <= tq) ? kk : 0u;
                }
                {
                    f32x2 s2 = {0.f, 0.f};
#pragma unroll
                    for (int r = 0; r < 16; r += 2) { int r0 = __float_as_int(accb[r]), r1 = __float_as_int(accb[r + 1]); r0 = r0 > 0 ? r0 : 0; r1 = r1 > 0 ? r1 : 0;
                        s2 = __builtin_elementwise_fma((f32x2){__int_as_float(r0), __int_as_float(r1)}, (f32x2){wv[r], wv[r + 1]}, s2); }
                    float s = s2[0] + s2[1];
                    asm volatile("" : "+v"(s));
                    const unsigned u = __float_as_uint(s);
                    const unsigned kk = u ^ ((unsigned)((int)u >> 31) | 0x80000000u);
                    key[kt + 1] = (32 * (kt + 1) + r32 <= tq) ? kk : 0u;
                }
                __builtin_amdgcn_sched_barrier(0);
            }
        }
    }
    unsigned T = 0u;
    if (t0 + 1 >= TOPK) {
        bool done = tq < TOPK;
        unsigned kmx = 0u, kmn = 0xFFFFFFFFu;
#pragma unroll
        for (int k8 = 0; k8 < 16; ++k8) {
            if (k8 * 8 < nkt) {
#pragma unroll
                for (int j = 0; j < 8; ++j) { const unsigned kv = key[k8 * 8 + j]; kmx = kmx > kv ? kmx : kv; const unsigned kw = kv - 1u; kmn = kmn < kw ? kmn : kw; }
            }
        }
#define IDX_HRED(x, OP) do { unsigned y_;                                                                                          \
            y_ = (unsigned)__builtin_amdgcn_update_dpp(0, (int)(x), 0xB1, 0xF, 0xF, true);  (x) = OP((x), y_);                        \
            y_ = (unsigned)__builtin_amdgcn_update_dpp(0, (int)(x), 0x4E, 0xF, 0xF, true);  (x) = OP((x), y_);                        \
            y_ = (unsigned)__builtin_amdgcn_update_dpp(0, (int)(x), 0x141, 0xF, 0xF, true); (x) = OP((x), y_);                        \
            y_ = (unsigned)__builtin_amdgcn_update_dpp(0, (int)(x), 0x140, 0xF, 0xF, true); (x) = OP((x), y_);                        \
            { auto rr_ = __builtin_amdgcn_permlane16_swap((x), (x), false, false); (x) = OP((unsigned)rr_[0], (unsigned)rr_[1]); } } while (0)
#define IDX_UMAX(a, b) ((a) > (b) ? (a) : (b))
#define IDX_UMIN(a, b) ((a) < (b) ? (a) : (b))
        IDX_HRED(kmx, IDX_UMAX); IDX_HRED(kmn, IDX_UMIN);
        unsigned lo = kmn + 1u, hi = kmx + 1u; float wl = (float)(tq + 1 - TOPK), wh = (float)TOPK; int side = 0;
        unsigned cand0;
        {   const int ml = (int)lo >> 31, mh = (int)hi >> 31;
            const float fl = __uint_as_float(lo ^ (((unsigned)ml & 0x80000000u) | ~(unsigned)ml)), fh = __uint_as_float(hi ^ (((unsigned)mh & 0x80000000u) | ~(unsigned)mh));
            const float l2n = __builtin_amdgcn_logf((float)(tq + 1));
            const float z = __builtin_sqrtf(fmaxf(1.3862944f * (l2n - 8.f), 0.f)) - 0.9f, zx = __builtin_sqrtf(1.3862944f * l2n);
            const float fc = 0.5f * (fl + fh) + fmaxf(z, 0.f) * (fh - fl) * 0.5f * __builtin_amdgcn_rcpf(zx);
            const unsigned u = __float_as_uint(fc);
            cand0 = u ^ ((unsigned)((int)u >> 31) | 0x80000000u); }
        for (int it = 0; it < 256; ++it) {
            unsigned cand;
            if (it == 0) cand = cand0;
            else if ((it & 7) == 7) cand = lo + ((hi - lo) >> 1);
            else {
                const int ml = (int)lo >> 31, mh = (int)hi >> 31;
                const float fl = __uint_as_float(lo ^ (((unsigned)ml & 0x80000000u) | ~(unsigned)ml)), fh = __uint_as_float(hi ^ (((unsigned)mh & 0x80000000u) | ~(unsigned)mh));
                const float fc = (fl * wh + fh * wl) * __builtin_amdgcn_rcpf(wl + wh);
                const unsigned u = __float_as_uint(fc);
                cand = u ^ ((unsigned)((int)u >> 31) | 0x80000000u);
            }
            { const unsigned l1 = lo + 1u, h1 = hi - 1u; cand = cand > l1 ? cand : l1; cand = cand < h1 ? cand : h1; }
            unsigned c = 0u;
#pragma unroll
            for (int k8 = 0; k8 < 16; ++k8) {
                if (k8 * 8 < nkt) {
                    asm volatile("v_cmp_ge_u32_e64 s[20:21], %1, %9\n\tv_cmp_ge_u32_e64 s[22:23], %2, %9\n\tv_cmp_ge_u32_e64 s[24:25], %3, %9\n\tv_cmp_ge_u32_e64 s[26:27], %4, %9\n\t"
                                 "v_addc_co_u32_e64 %0, s[28:29], %0, 0, s[20:21]\n\tv_addc_co_u32_e64 %0, s[28:29], %0, 0, s[22:23]\n\tv_addc_co_u32_e64 %0, s[28:29], %0, 0, s[24:25]\n\tv_addc_co_u32_e64 %0, s[28:29], %0, 0, s[26:27]\n\t"
                                 "v_cmp_ge_u32_e64 s[20:21], %5, %9\n\tv_cmp_ge_u32_e64 s[22:23], %6, %9\n\tv_cmp_ge_u32_e64 s[24:25], %7, %9\n\tv_cmp_ge_u32_e64 s[26:27], %8, %9\n\t"
                                 "v_addc_co_u32_e64 %0, s[28:29], %0, 0, s[20:21]\n\tv_addc_co_u32_e64 %0, s[28:29], %0, 0, s[22:23]\n\tv_addc_co_u32_e64 %0, s[28:29], %0, 0, s[24:25]\n\tv_addc_co_u32_e64 %0, s[28:29], %0, 0, s[26:27]"
                                 : "+v"(c)
                                 : "v"(key[k8 * 8 + 0]), "v"(key[k8 * 8 + 1]), "v"(key[k8 * 8 + 2]), "v"(key[k8 * 8 + 3]), "v"(key[k8 * 8 + 4]), "v"(key[k8 * 8 + 5]), "v"(key[k8 * 8 + 6]), "v"(key[k8 * 8 + 7]), "v"(cand)
                                 : "s20", "s21", "s22", "s23", "s24", "s25", "s26", "s27", "s28", "s29");
                }
            }
            asm volatile("s_nop 1" : "+v"(c));
            c += (unsigned)__builtin_amdgcn_update_dpp(0, (int)c, 0xB1, 0xF, 0xF, true);  c += (unsigned)__builtin_amdgcn_update_dpp(0, (int)c, 0x4E, 0xF, 0xF, true);
            c += (unsigned)__builtin_amdgcn_update_dpp(0, (int)c, 0x141, 0xF, 0xF, true); c += (unsigned)__builtin_amdgcn_update_dpp(0, (int)c, 0x140, 0xF, 0xF, true);
            { auto rr = __builtin_amdgcn_permlane16_swap(c, c, false, false); c = rr[0] + rr[1]; }
            if (!done) {
                if (c == (unsigned)TOPK) { T = cand; done = true; }
                else if (c > (unsigned)TOPK) { lo = cand; wl = (float)(c - (unsigned)TOPK); wh = side > 0 ? wh * 0.5f : wh; side = 1; }
                else { hi = cand; wh = (float)((unsigned)TOPK - c); wl = side < 0 ? wl * 0.5f : wl; side = -1; }
                if (!done && hi - lo <= 1u) { T = lo; done = true; }
            }
            if (__all(done)) break;
        }
        if (!done) T = lo;
#undef IDX_HRED
#undef IDX_UMAX
#undef IDX_UMIN
        if (tq < TOPK) T = 0u;
    }
    if (T == 0u) T = 1u;
    const int nw = ((t0 >> 8) + 1) * 8;
    unsigned a0 = 0u, a1 = 0u, b0 = 0u, b1 = 0u;
#define IDX_DEP(j) { const unsigned long long balA = __ballot(key[(j)] >= T), balB = __ballot(key[(j) + 64] >= T); \
        const unsigned lA = (unsigned)balA, hA = (unsigned)(balA >> 32), lB = (unsigned)balB, hB = (unsigned)(balB >> 32); \
        asm volatile("s_nop 3\n\tv_writelane_b32 %0, %4, %8\n\tv_writelane_b32 %1, %5, %8\n\tv_writelane_b32 %2, %6, %8\n\tv_writelane_b32 %3, %7, %8" \
                     : "+v"(a0), "+v"(a1), "+v"(b0), "+v"(b1) : "s"(lA), "s"(hA), "s"(lB), "s"(hB), "n"(j)); }
#define IDX_DEP4(j) IDX_DEP(j) IDX_DEP((j) + 1) IDX_DEP((j) + 2) IDX_DEP((j) + 3)
#define IDX_DEP16(j) IDX_DEP4(j) IDX_DEP4((j) + 4) IDX_DEP4((j) + 8) IDX_DEP4((j) + 12)
    IDX_DEP16(0) IDX_DEP16(16) IDX_DEP16(32) IDX_DEP16(48)
#undef IDX_DEP16
#undef IDX_DEP4
#undef IDX_DEP
    unsigned* m0 = mask + (size_t)(b * SEQ + t0) * 128; unsigned* m1 = m0 + 128;
    if (lane < nw) { m0[lane] = a0; m1[lane] = a1; }
    if (64 + lane < nw) { m0[64 + lane] = b0; m1[64 + lane] = b1; }
}

__device__ __forceinline__ void sgu_unit(const Frame& F, const bf16_t* Z, bf16_t* YA, const float* lng, const float* lnb, const bf16_t* wsb, const float* bs_, int b, int n, int half, const int tz) {
    LAS float* part = (LAS float*)F.lds;
    LAS float* stat = (LAS float*)(F.lds + 8192);
    LAS bf16_t* VT = (LAS bf16_t*)(F.lds + 8192 + 1024 + F.wave * 8704);
    LAS float* CT = (LAS float*)(F.lds + 8192 + 1024 + 8 * 8704 + F.wave * 4352);
    const int w = F.wave, lane = tz & 63, tid_ = tz;
    const size_t R0 = (size_t)b * SEQ + (size_t)n * 128;
    __syncthreads();
    {
        const bf16_t* Vs = Z + R0 * LDZ + ZV + 128 * w;
        const int ch = lane & 15, rq = lane >> 4;
#pragma unroll 8
        for (int i = 0; i < 32; ++i) {
            const int row = rq + 4 * i;
            const u32x4 x = *(const u32x4*)(Vs + (size_t)row * LDZ + 8 * ch);
            const float x0 = bf_lo(x.x), x1 = bf_hi(x.x), x2 = bf_lo(x.y), x3 = bf_hi(x.y), x4 = bf_lo(x.z), x5 = bf_hi(x.z), x6 = bf_lo(x.w), x7 = bf_hi(x.w);
            float s = ((x0 + x1) + (x2 + x3)) + ((x4 + x5) + (x6 + x7));
            float q = ((x0 * x0 + x1 * x1) + (x2 * x2 + x3 * x3)) + ((x4 * x4 + x5 * x5) + (x6 * x6 + x7 * x7));
#define DPPADD(v, ctl) v += __int_as_float(__builtin_amdgcn_update_dpp(0, __float_as_int(v), ctl, 0xF, 0xF, true))
            DPPADD(s, 0xB1); DPPADD(q, 0xB1); DPPADD(s, 0x4E); DPPADD(q, 0x4E); DPPADD(s, 0x141); DPPADD(q, 0x141); DPPADD(s, 0x140); DPPADD(q, 0x140);
#undef DPPADD
            if (ch == 0) { part[(row * 8 + w) * 2] = s; part[(row * 8 + w) * 2 + 1] = q; }
        }
    }
    __syncthreads();
    if (tid_ < 128) {
        float s = 0.f, q = 0.f;
#pragma unroll
        for (int k = 0; k < 8; ++k) { s += part[(tid_ * 8 + k) * 2]; q += part[(tid_ * 8 + k) * 2 + 1]; }
        const float mean = s * (1.f / SGW); const float var = fmaxf(q * (1.f / SGW) - mean * mean, 0.f);
        stat[tid_ * 2] = mean; stat[tid_ * 2 + 1] = __builtin_amdgcn_rsqf(var + LN_EPS);
    }
    __syncthreads();
    const int r32 = lane & 31, hi = lane >> 5;
    const int g = 4 * half + (w >> 1);
    const bf16_t* wsg = wsb + (size_t)g * 128 * 128;
    const bf16_t* Vg = Z + R0 * LDZ + ZV + 128 * g;
    const bf16_t* Ug = Z + R0 * LDZ + ZU + 128 * g;
    bf16_t* Yg = YA + R0 * SGW + 128 * g;
#pragma unroll 1
    for (int qq = 0; qq < 2; ++qq) {
        const int qtr = 2 * (w & 1) + qq;
        {
            const int ch = lane & 3, rq = lane >> 2;
            const int c0 = 128 * g + 32 * qtr + 8 * ch;
            const f32x4 g0 = *(const f32x4*)(lng + c0), g1 = *(const f32x4*)(lng + c0 + 4), b0 = *(const f32x4*)(lnb + c0), b1 = *(const f32x4*)(lnb + c0 + 4);
#pragma unroll
            for (int i = 0; i < 8; ++i) {
                const int s = rq + 16 * i;
                const u32x4 x4 = *(const u32x4*)(Vg + (size_t)s * LDZ + 32 * qtr + 8 * ch);
                const float mean = stat[s * 2], rstd = stat[s * 2 + 1];
                float x[8] = {bf_lo(x4.x), bf_hi(x4.x), bf_lo(x4.y), bf_hi(x4.y), bf_lo(x4.z), bf_hi(x4.z), bf_lo(x4.w), bf_hi(x4.w)};
#pragma unroll
                for (int j = 0; j < 8; ++j) { const float gg = j < 4 ? g0[j & 3] : g1[j & 3], bb = j < 4 ? b0[j & 3] : b1[j & 3];
                    const float y = (x[j] - mean) * rstd * gg + bb;
                    VT[(8 * ch + j) * 136 + s] = (bf16_t)(cvt_pk_bf16(y, 0.f) & 0xffffu); }
            }
        }
        LDS_WAIT(); asm volatile("" ::: "memory");
        bf16x8 bfr[8];
#pragma unroll
        for (int ks = 0; ks < 8; ++ks) bfr[ks] = *(const LAS bf16x8*)(VT + r32 * 136 + 16 * ks + 8 * hi);
#pragma unroll 1
        for (int mt = 0; mt < 4; ++mt) {
            f32x16 acc = {};
            const int t = 32 * mt + r32;
#pragma unroll
            for (int ks = 0; ks < 8; ++ks) {
                if (ks < 2 * mt + 2) {
                    const bf16x8 a = *(const bf16x8*)(wsg + (size_t)t * 128 + 16 * ks + 8 * hi);
                    acc = __builtin_amdgcn_mfma_f32_32x32x16_bf16(a, bfr[ks], acc, 0, 0, 0);
                }
            }
#pragma unroll
            for (int r = 0; r < 16; ++r) CT[((r & 3) + 8 * (r >> 2) + 4 * hi) * 34 + r32] = acc[r];
            LDS_WAIT(); asm volatile("" ::: "memory");
#pragma unroll
            for (int it = 0; it < 2; ++it) {
                const int tl = (lane >> 2) + 16 * it, cc = (lane & 3) * 8, tt = 32 * mt + tl;
                const float bias = bs_[g * 128 + tt];
                const u32x4 uu = *(const u32x4*)(Ug + (size_t)tt * LDZ + 32 * qtr + cc);
                const LAS float* cr = CT + tl * 34 + cc;
                u32x4 o;
                o.x = cvt_pk_bf16((cr[0] + bias) * bf_lo(uu.x), (cr[1] + bias) * bf_hi(uu.x)); o.y = cvt_pk_bf16((cr[2] + bias) * bf_lo(uu.y), (cr[3] + bias) * bf_hi(uu.y));
                o.z = cvt_pk_bf16((cr[4] + bias) * bf_lo(uu.z), (cr[5] + bias) * bf_hi(uu.z)); o.w = cvt_pk_bf16((cr[6] + bias) * bf_lo(uu.w), (cr[7] + bias) * bf_hi(uu.w));
                *(u32x4*)(Yg + (size_t)tt * SGW + 32 * qtr + cc) = o;
            }
            LDS_WAIT(); asm volatile("" ::: "memory");
        }
    }
}

namespace att {
constexpr int D = 128, KVBLK = 64, QBLK = 32, QB = 256;
constexpr int SHM_V = KVBLK * D * 2, SHM_K = KVBLK * D * 2;
constexpr float SCALE = 0.08838834764831845f;
constexpr float THR = 8.f;
constexpr int NBUF = 4;
constexpr int KRING = NBUF * SHM_V, WS_OFF = LDSCTL_OFF + 8192, TB_OFF = WS_OFF + NWAVES * 64 * 4, ATT_LDS = TB_OFF + 2048;
static_assert(ATT_LDS <= LDS_BYTES, "attention LDS map");
#define KSWZ(row, colB) ((row) * 256 + ((colB) ^ (((row) & 7) << 4)))
#define SBAR() __builtin_amdgcn_sched_barrier(0)
__device__ __forceinline__ int v_st(int k, int c) { const int kk = (k & ~0xC) | ((k & 4) << 1) | ((k & 8) >> 1); return ((kk >> 3) * 4 + (c >> 5)) * 512 + ((kk & 7) * 32 + (c & 31)) * 2; }
__device__ __forceinline__ int v_rd_base(int lane) { return ((lane & 3) << 3) | (((lane >> 2) & 3) << 6) | (((lane >> 4) & 1) << 5) | (((lane >> 5) & 1) << 8); }
constexpr int v_rd_off(int d0, int ks, int half) { return d0 * 512 + ks * 4096 + half * 2048; }
__device__ __forceinline__ int crow(int r, int hi) { return (r & 3) + 8 * (r >> 2) + 4 * hi; }
__device__ __forceinline__ void partialSM(f32x16& p0, f32x16& p1, float& m_reg, float l_reg, float& alpha) {
    float pmax = p0[0];
#pragma unroll
    for (int r = 1; r < 16; ++r) pmax = fmaxf(pmax, p0[r]);
#pragma unroll
    for (int r = 0; r < 16; ++r) pmax = fmaxf(pmax, p1[r]);
    { auto rr = __builtin_amdgcn_permlane32_swap(__float_as_uint(pmax), __float_as_uint(pmax), false, false);
      pmax = fmaxf(__uint_as_float(rr[0]), __uint_as_float(rr[1])); }
    constexpr float THRL = THR * 1.4426950408889634f;
    const bool fresh = (l_reg == 0.f) & (pmax < -THRL) & (pmax > -3.0e38f);
    if (__builtin_expect(!__any((pmax > THRL) | fresh), 1)) { alpha = 1.f; }
    else { const float d = fresh ? pmax : fmaxf(pmax, 0.f); alpha = fresh ? 1.f : __builtin_amdgcn_exp2f(-d); m_reg += d;
#pragma unroll
        for (int r = 0; r < 16; ++r) { p0[r] -= d; p1[r] -= d; } }
#pragma unroll
    for (int r = 0; r < 16; ++r) p0[r] = __builtin_amdgcn_exp2f(p0[r]);
}
__device__ __forceinline__ void finishSM(f32x16& p0, f32x16& p1, float alpha, float& l_reg, bf16x8& pa0, bf16x8& pa1, bf16x8& pa2, bf16x8& pa3) {
#pragma unroll
    for (int r = 0; r < 16; ++r) p1[r] = __builtin_amdgcn_exp2f(p1[r]);
    float ps = 0;
#pragma unroll
    for (int r = 0; r < 16; ++r) ps += p0[r];
#pragma unroll
    for (int r = 0; r < 16; ++r) ps += p1[r];
    { auto rr = __builtin_amdgcn_permlane32_swap(__float_as_uint(ps), __float_as_uint(ps), false, false);
      ps = __uint_as_float(rr[0]) + __uint_as_float(rr[1]); }
    l_reg = l_reg * alpha + ps;
#define PK4(P, B_, OUT) do { unsigned a0 = cvt_pk_bf16(P[B_+0], P[B_+1]), a1 = cvt_pk_bf16(P[B_+2], P[B_+3]);                          \
        unsigned b0 = cvt_pk_bf16(P[B_+4], P[B_+5]), b1 = cvt_pk_bf16(P[B_+6], P[B_+7]);                                             \
        auto r0 = __builtin_amdgcn_permlane32_swap(a0, b0, false, false); auto r1 = __builtin_amdgcn_permlane32_swap(a1, b1, false, false); \
        u32x4 w = {r0[0], r1[0], r0[1], r1[1]}; OUT = *reinterpret_cast<bf16x8*>(&w); } while (0)
    PK4(p0, 0, pa0); PK4(p0, 8, pa1); PK4(p1, 0, pa2); PK4(p1, 8, pa3);
#undef PK4
}
template <int KB>
__device__ __forceinline__ void qkt(f32x16& p0, f32x16& p1, const char* K_lds, int r32, int hi, const bf16x8* qr) {
    p0 = f32x16{}; p1 = f32x16{};
    const char* kb[4];
#pragma unroll
    for (int dd = 0; dd < 4; ++dd) kb[dd] = K_lds + KB * SHM_K + KSWZ(r32, (dd * 16 + hi * 8) * 2);
#pragma unroll
    for (int d0 = 0; d0 < 8; ++d0) { const char* a = kb[d0 & 3] + (d0 >> 2) * 128;
        bf16x8 b0 = *reinterpret_cast<const bf16x8*>(a);
        bf16x8 b1 = *reinterpret_cast<const bf16x8*>(a + 32 * 256);
        p0 = __builtin_amdgcn_mfma_f32_32x32x16_bf16(b0, qr[d0], p0, 0, 0, 0);
        p1 = __builtin_amdgcn_mfma_f32_32x32x16_bf16(b1, qr[d0], p1, 0, 0, 0); }
}
template <int VB>
__device__ __forceinline__ void pv_tile(f32x16* o, int vb0, bf16x8 pa0, bf16x8 pa1, bf16x8 pa2, bf16x8 pa3) {
#define TRRD(dst, off) asm volatile("ds_read_b64_tr_b16 %0, %1 offset:%2" : "=&v"(dst) : "v"(vb0), "i"(off) : "memory")
#define PV_D0(d0) do { s16x4 l0, l1, l2, l3, h0, h1, h2, h3; constexpr int b_ = VB * SHM_V + v_rd_off(d0, 0, 0); \
        TRRD(l0, b_); TRRD(h0, b_ + 2048); TRRD(l1, b_ + 4096); TRRD(h1, b_ + 6144); TRRD(l2, b_ + 8192); TRRD(h2, b_ + 10240); TRRD(l3, b_ + 12288); TRRD(h3, b_ + 14336); \
        asm volatile("s_waitcnt lgkmcnt(0)" ::: "memory"); SBAR();   \
        o[d0] = __builtin_amdgcn_mfma_f32_32x32x16_bf16((bf16x8){l0[0], l0[1], l0[2], l0[3], h0[0], h0[1], h0[2], h0[3]}, pa0, o[d0], 0, 0, 0);   \
        o[d0] = __builtin_amdgcn_mfma_f32_32x32x16_bf16((bf16x8){l1[0], l1[1], l1[2], l1[3], h1[0], h1[1], h1[2], h1[3]}, pa1, o[d0], 0, 0, 0);   \
        o[d0] = __builtin_amdgcn_mfma_f32_32x32x16_bf16((bf16x8){l2[0], l2[1], l2[2], l2[3], h2[0], h2[1], h2[2], h2[3]}, pa2, o[d0], 0, 0, 0);   \
        o[d0] = __builtin_amdgcn_mfma_f32_32x32x16_bf16((bf16x8){l3[0], l3[1], l3[2], l3[3], h3[0], h3[1], h3[2], h3[3]}, pa3, o[d0], 0, 0, 0); } while (0)
    PV_D0(0); PV_D0(1); PV_D0(2); PV_D0(3);
#undef PV_D0
#undef TRRD
}
__device__ __forceinline__ void mask_init(f32x16& p0, f32x16& p1, unsigned w0, unsigned w1, int dq, int hi, bool near, const float* tb, float mneg) {
    const unsigned mb = __float_as_uint(mneg);
    unsigned NEGINF = 0xff800000u; asm volatile("" : "+s"(NEGINF));
    const int n0 = (int)~(w0 >> (4 * hi)), n1 = (int)~(w1 >> (4 * hi));
#define MI_SEL(dst, n, c, val) { unsigned u_; asm("v_bfe_i32 %0, %1, " #c ", 1" : "=v"(u_) : "v"(n)); asm("v_bfi_b32 %0, %1, %2, %3" : "=v"(dst) : "v"(u_), "s"(NEGINF), "v"(val)); }
    if (near) {
        const float* tp = tb + ((((dq - 4 * hi) & 255) + 256 - 59));
#define MI_NEAR(r, c) { const float b0_ = tp[59 - c] + mneg, b1_ = tp[27 - c] + mneg; MI_SEL(p0[r], n0, c, b0_) MI_SEL(p1[r], n1, c, b1_) }
        MI_NEAR(0, 0) MI_NEAR(1, 1) MI_NEAR(2, 2) MI_NEAR(3, 3) MI_NEAR(4, 8) MI_NEAR(5, 9) MI_NEAR(6, 10) MI_NEAR(7, 11)
        MI_NEAR(8, 16) MI_NEAR(9, 17) MI_NEAR(10, 18) MI_NEAR(11, 19) MI_NEAR(12, 24) MI_NEAR(13, 25) MI_NEAR(14, 26) MI_NEAR(15, 27)
#undef MI_NEAR
    } else {
#define MI_FAR(r, c) { MI_SEL(p0[r], n0, c, mb) MI_SEL(p1[r], n1, c, mb) }
        MI_FAR(0, 0) MI_FAR(1, 1) MI_FAR(2, 2) MI_FAR(3, 3) MI_FAR(4, 8) MI_FAR(5, 9) MI_FAR(6, 10) MI_FAR(7, 11)
        MI_FAR(8, 16) MI_FAR(9, 17) MI_FAR(10, 18) MI_FAR(11, 19) MI_FAR(12, 24) MI_FAR(13, 25) MI_FAR(14, 26) MI_FAR(15, 27)
#undef MI_FAR
    }
#undef MI_SEL
}
template <int KB>
__device__ __forceinline__ void qkt_acc(f32x16& p0, f32x16& p1, const char* K_lds, int r32, int hi, const bf16x8* qr) {
    const char* kb[4];
#pragma unroll
    for (int dd = 0; dd < 4; ++dd) kb[dd] = K_lds + KB * SHM_K + KSWZ(r32, (dd * 16 + hi * 8) * 2);
#pragma unroll
    for (int d0 = 0; d0 < 8; ++d0) { const char* a = kb[d0 & 3] + (d0 >> 2) * 128;
        bf16x8 b0 = *reinterpret_cast<const bf16x8*>(a);
        bf16x8 b1 = *reinterpret_cast<const bf16x8*>(a + 32 * 256);
        p0 = __builtin_amdgcn_mfma_f32_32x32x16_bf16(b0, qr[d0], p0, 0, 0, 0);
        p1 = __builtin_amdgcn_mfma_f32_32x32x16_bf16(b1, qr[d0], p1, 0, 0, 0); }
}
struct KRing { bf16x8 f[3][2]; };
#define KSWZ16(row, colB) ((row) * 256 + ((colB) ^ (((row) & 15) << 4)))
struct KAddr { unsigned a[8]; };
__device__ __forceinline__ KAddr k_addr(int r32, int hi) { KAddr k;
#pragma unroll
    for (int d0 = 0; d0 < 8; ++d0) k.a[d0] = (unsigned)KSWZ16(r32, d0 * 32 + hi * 16);
    return k; }
template <int KB>
__device__ __forceinline__ void qkt_head(KRing& R, const LAS char* kl, const KAddr& ka) {
#pragma unroll
    for (int d0 = 0; d0 < 3; ++d0) { const LAS char* a = kl + ka.a[d0] + KB * SHM_K;
        R.f[d0][0] = *(const LAS bf16x8*)a; R.f[d0][1] = *(const LAS bf16x8*)(a + 32 * 256); }
}
template <int KB>
__device__ __forceinline__ void qkt_body(f32x16& p0, f32x16& p1, KRing& R, const LAS char* kl, const KAddr& ka, const bf16x8* qr) {
#pragma unroll
    for (int d0 = 0; d0 < 8; ++d0) {
        p0 = __builtin_amdgcn_mfma_f32_32x32x16_bf16(R.f[d0 % 3][0], qr[d0], p0, 0, 0, 0);
        p1 = __builtin_amdgcn_mfma_f32_32x32x16_bf16(R.f[d0 % 3][1], qr[d0], p1, 0, 0, 0);
        if (d0 < 5) { const LAS char* a = kl + ka.a[d0 + 3] + KB * SHM_K;
            R.f[d0 % 3][0] = *(const LAS bf16x8*)a; R.f[d0 % 3][1] = *(const LAS bf16x8*)(a + 32 * 256); }
        SBAR();
    }
}
struct BlockRef { const bf16_t* Q; const bf16_t* K; const bf16_t* V; bf16_t* O; const unsigned* M; int P0; };
struct Seam { bf16x8 qr[8]; u32x2 mw, mwn; };
#define VMWN(n) asm volatile("s_waitcnt vmcnt(%0)" :: "i"(n) : "memory")
#define ABAR() __builtin_amdgcn_s_barrier()
#define DMA_T(gb, off, dst) do { const GAS char* g0_ = (gb); const GAS char* g1_ = g0_ + 32 * 256; asm volatile("" : "+s"(g0_), "+s"(g1_)); LAS char* d_ = (dst); \
        __builtin_amdgcn_global_load_lds((const GAS unsigned*)(g0_ + (off)), (LAS unsigned*)d_, 16, 0, 0); \
        __builtin_amdgcn_global_load_lds((const GAS unsigned*)(g1_ + (off)), (LAS unsigned*)(d_ + 8192), 16, 0, 0); } while (0)
#define MLOADW(dst, base_u, off) asm volatile("s_nop 4\n\tglobal_load_dwordx2 %0, %1, %2" : "=v"(dst) : "v"(off), "s"(base_u) : "memory")
struct DmaLane { unsigned koff, voff; };
__device__ __forceinline__ DmaLane dma_lane(int tid) {
    DmaLane d; const unsigned t = (unsigned)tid, krow = t >> 4;
    d.koff = krow * 256u + (((t & 15u) << 4) ^ ((krow & 15u) << 4));
    const unsigned kk = (t >> 7) * 8 + ((t & 31u) >> 2), vk = (kk & ~0xCu) | ((kk & 4u) << 1) | ((kk & 8u) >> 1);
    d.voff = vk * 256u + ((((t >> 5) & 3u) * 32 + (t & 3u) * 8) * 2);
    return d;
}
constexpr size_t TILEB = (size_t)KVBLK * 256;
__device__ __forceinline__ void attn_prime(const BlockRef& cur, LAS char* ldsL, Seam& S, const int tid) {
    const int wid = __builtin_amdgcn_readfirstlane(tid >> 6), lane = tid & 63, r32 = lane & 31, hi = lane >> 5;
    const DmaLane dl = dma_lane(tid); const unsigned ldsw = (unsigned)wid * 1024u;
    const unsigned qoff = (unsigned)((r32 * LDZ + hi * 8) * 2);
    const GAS char* qb_ = (const GAS char*)(cur.Q + (size_t)(cur.P0 + wid * QBLK) * LDZ); asm volatile("" : "+s"(qb_));
#pragma unroll
    for (int d0 = 0; d0 < 8; ++d0) S.qr[d0] = *(const GAS bf16x8*)(qb_ + d0 * 32 + qoff);
    { const GAS char* mr_ = (const GAS char*)(cur.M + (size_t)(cur.P0 + wid * QBLK) * 128); asm volatile("" : "+s"(mr_));
      const unsigned mo0 = (unsigned)(r32 * 512), mo1 = mo0 + 8u; MLOADW(S.mw, mr_, mo0); MLOADW(S.mwn, mr_, mo1); }
    DMA_T((const GAS char*)cur.K, dl.koff, ldsL + KRING + ldsw);            DMA_T((const GAS char*)cur.V, dl.voff, ldsL + ldsw);
    DMA_T((const GAS char*)cur.K + TILEB, dl.koff, ldsL + KRING + SHM_K + ldsw); DMA_T((const GAS char*)cur.V + TILEB, dl.voff, ldsL + SHM_V + ldsw);
    asm volatile("s_waitcnt vmcnt(0) lgkmcnt(0)" ::: "memory"); asm volatile("" : "+v"(S.mw), "+v"(S.mwn)); ABAR();
    DMA_T((const GAS char*)cur.K + 2 * TILEB, dl.koff, ldsL + KRING + 2 * SHM_K + ldsw); DMA_T((const GAS char*)cur.V + 2 * TILEB, dl.voff, ldsL + 2 * SHM_V + ldsw);
}
__device__ __forceinline__ void attn_block(const BlockRef& cur, const BlockRef& nxt, char* lds, LAS char* ldsL, Seam& S, const int tid) {
    const int wid = __builtin_amdgcn_readfirstlane(tid >> 6), lane = tid & 63, r32 = lane & 31, hi = lane >> 5;
    const int NT = cur.P0 / KVBLK + 4;
    const int qlo = cur.P0 + wid * QBLK, qpos = qlo + r32;
    char* V_lds = lds; char* K_lds = lds + KRING;
    float* ws = (float*)(lds + WS_OFF) + wid * 64; float* li_l = ws; float* al_l = ws + 32;
    const float* tb = (const float*)(lds + TB_OFF);
    const GAS char* mrow_u = (const GAS char*)(cur.M + (size_t)qlo * 128); asm volatile("" : "+s"(mrow_u));
    const GAS char* nrow_u = (const GAS char*)(nxt.M + (size_t)(nxt.P0 + wid * QBLK) * 128); asm volatile("" : "+s"(nrow_u));
    const unsigned moff = (unsigned)(r32 * 512);
    float m_reg = 0.f, l_reg = 0; f32x16 o[4] = {};
    const DmaLane dl = dma_lane(tid); const unsigned ldsw = (unsigned)wid * 1024u;
    LAS char* const dK = ldsL + KRING + ldsw; LAS char* const dV = ldsL + ldsw;
    const GAS char* const cK = (const GAS char*)cur.K; const GAS char* const cV = (const GAS char*)cur.V; const GAS char* const nK = (const GAS char*)nxt.K; const GAS char* const nV = (const GAS char*)nxt.V;
    const int vb0 = (int)(uintptr_t)V_lds + v_rd_base(lane);
    const LAS char* const kl = ldsL + KRING; const KAddr ka = k_addr(r32, hi);
#define RESC(a) do { if (__any((a) < 1.f)) { _Pragma("unroll") for (int d_ = 0; d_ < 4; ++d_) _Pragma("unroll") for (int r = 0; r < 16; ++r) o[d_][r] *= (a); } } while (0)
#define MINIT(P0_, P1_, t) do { const int kb_ = (t) * KVBLK; mask_init(P0_, P1_, mw.x, mw.y, qpos - kb_, hi, kb_ > qlo - 192, tb, -m_reg); } while (0)
#define ISSUE(t, PB) do { const int jm_ = (t) + 2, jt_ = (t) + 3;                                                                               \
        { const GAS char* mb_ = jm_ < NT ? mrow_u : nrow_u; const unsigned mo_ = moff + 8u * (unsigned)(jm_ < NT ? jm_ : jm_ - NT); MLOADW(mwn, mb_, mo_); }   \
        DMA_T(jt_ < NT ? cK + (size_t)jt_ * TILEB : nK + (size_t)(jt_ - NT) * TILEB, dl.koff, dK + (PB) * SHM_K);                             \
        DMA_T(jt_ < NT ? cV + (size_t)jt_ * TILEB : nV + (size_t)(jt_ - NT) * TILEB, dl.voff, dV + (PB) * SHM_V); } while (0)
#define CLOSE() do { VMWN(4); asm volatile("" : "+v"(mwn)); mw = mwn; ABAR(); } while (0)
    f32x16 pA0, pA1, pB0, pB1; float mnA, mnB, alA, alB; bf16x8 pa0, pa1, pa2, pa3;
    u32x2 mw = S.mw, mwn = S.mwn;
    KRing R;
    qkt_head<0>(R, kl, ka); SBAR();
    MINIT(pA0, pA1, 0);
    SBAR(); qkt_body<0>(pA0, pA1, R, kl, ka, S.qr);
    partialSM(pA0, pA1, m_reg, l_reg, alA); SBAR();
    CLOSE(); ISSUE(0, 3); SBAR();
#define STEP(PX0, PX1, mnX, alX, PY0, PY1, alY, t, B, PB) do {                                                                 \
        qkt_head<B>(R, kl, ka); SBAR();                                                                                          \
        MINIT(PX0, PX1, (t));                                                                                                 \
        SBAR(); qkt_body<B>(PX0, PX1, R, kl, ka, S.qr);                                                                          \
        finishSM(PY0, PY1, alY, l_reg, pa0, pa1, pa2, pa3); SBAR();                                                           \
        pv_tile<PB>(o, vb0, pa0, pa1, pa2, pa3); partialSM(PX0, PX1, m_reg, l_reg, alX);                                        \
        RESC(alX); SBAR();                                                                                                    \
        CLOSE(); ISSUE((t), PB); SBAR(); } while (0)
    int t = 1;
    for (; t + 3 < NT; t += 4) {
        STEP(pB0, pB1, mnB, alB, pA0, pA1, alA, t, 1, 0);
        STEP(pA0, pA1, mnA, alA, pB0, pB1, alB, t + 1, 2, 1);
        STEP(pB0, pB1, mnB, alB, pA0, pA1, alA, t + 2, 3, 2);
        STEP(pA0, pA1, mnA, alA, pB0, pB1, alB, t + 3, 0, 3);
    }
    STEP(pB0, pB1, mnB, alB, pA0, pA1, alA, NT - 3, 1, 0);
    STEP(pA0, pA1, mnA, alA, pB0, pB1, alB, NT - 2, 2, 1);
    STEP(pB0, pB1, mnB, alB, pA0, pA1, alA, NT - 1, 3, 2);
    { const GAS char* qb_ = (const GAS char*)(nxt.Q + (size_t)(nxt.P0 + wid * QBLK) * LDZ); asm volatile("" : "+s"(qb_));
      int t2 = tid; asm volatile("" : "+v"(t2));
      const unsigned qoff2 = (unsigned)((((t2 & 31) * LDZ) + ((t2 >> 5) & 1) * 8) * 2);
#pragma unroll
      for (int d0 = 0; d0 < 8; ++d0) S.qr[d0] = *(const GAS bf16x8*)(qb_ + d0 * 32 + qoff2); }
    SBAR();
    finishSM(pB0, pB1, alB, l_reg, pa0, pa1, pa2, pa3); SBAR(); pv_tile<3>(o, vb0, pa0, pa1, pa2, pa3);
    {
        const float rl = __builtin_amdgcn_rcpf(l_reg);
        bf16_t* Ow = cur.O + (size_t)(cur.P0 + wid * QBLK + r32) * 1024 + hi * 8;
#pragma unroll
        for (int d0 = 0; d0 < 4; ++d0)
#pragma unroll
            for (int pr = 0; pr < 2; ++pr) {
                const int rb = 8 * pr;
                unsigned a0 = cvt_pk_bf16(o[d0][rb + 0] * rl, o[d0][rb + 1] * rl), a1 = cvt_pk_bf16(o[d0][rb + 2] * rl, o[d0][rb + 3] * rl);
                unsigned b0 = cvt_pk_bf16(o[d0][rb + 4] * rl, o[d0][rb + 5] * rl), b1 = cvt_pk_bf16(o[d0][rb + 6] * rl, o[d0][rb + 7] * rl);
                auto s0 = __builtin_amdgcn_permlane32_swap(a0, b0, false, false); auto s1 = __builtin_amdgcn_permlane32_swap(a1, b1, false, false);
                *(u32x4*)(Ow + d0 * 32 + 16 * pr) = (u32x4){s0[0], s1[0], s0[1], s1[1]};
            }
    }
    S.mw = mw; S.mwn = mwn;
#undef RESC
#undef MINIT
#undef STEP
#undef ISSUE
#undef CLOSE
}
__device__ __forceinline__ void attn_item(char* lds, LAS char* ldsL, const bf16_t* Z, const bf16_t* KVC, const unsigned* mask, const float* rel_bias, bf16_t* YB, int b, int h, int x, const int tid_in) {
    int tid = tid_in; asm volatile("" : "+v"(tid));
    float* tb = (float*)(lds + TB_OFF);
    __syncthreads();
    if (tid < 256) {
        float v = 0.f;
        if (tid < 128) { int bk = tid; if (tid >= 16) { bk = 16 + (int)(__logf((float)tid * (1.f / 16.f)) * (16.f / 2.0794415416798357f)); bk = bk > 31 ? 31 : bk; }
            v = (rel_bias[bk * NHEAD + h] - rel_bias[31 * NHEAD + h]) * 1.4426950408889634f; }
        tb[tid] = v; tb[256 + tid] = v;
    }
    BlockRef c0, c1;
    c0.Q = Z + (size_t)b * SEQ * LDZ + ZQ + h * D; c0.K = KVC + ((size_t)b * NHEAD + h) * ((size_t)SEQ * 128); c0.V = KVC + ((size_t)(NB + b) * NHEAD + h) * ((size_t)SEQ * 128);
    c0.O = YB + (size_t)b * SEQ * 1024 + h * D; c0.M = mask + (size_t)b * SEQ * 128; c0.P0 = (15 - x) * QB;
    c1 = c0; c1.P0 = x * QB;
    Seam S;
    attn_prime(c0, ldsL, S, tid);
    attn_block(c0, c1, lds, ldsL, S, tid);
    attn_block(c1, c1, lds, ldsL, S, tid);
    asm volatile("s_waitcnt vmcnt(0)" ::: "memory");
    asm volatile("" :: "v"(S.mw), "v"(S.mwn));
}
#undef VMWN
#undef ABAR
#undef DMA_T
#undef MLOADW
}


#if defined(REF_IDX) || defined(REF_ATT)
__device__ __forceinline__ float bf2f(bf16_t v) { return __uint_as_float((unsigned)v << 16); }
__global__ void __launch_bounds__(256) ref_indexer(const bf16_t* Z, unsigned* mask) {
    __shared__ float q[1024]; __shared__ float w[16]; __shared__ unsigned keys[4096]; __shared__ unsigned cnt;
    const int row = blockIdx.x, b = row / SEQ, t = row % SEQ, tid = threadIdx.x;
    const bf16_t* zr = Z + (size_t)row * LDZ;
    for (int i = tid; i < 1024; i += 256) q[i] = bf2f(zr[ZQI + i]);
    if (tid < 16) w[tid] = bf2f(zr[ZWI + tid]) * 0.25f;
    __syncthreads();
    for (int s = tid; s < SEQ; s += 256) {
        unsigned k = 0u;
        if (s <= t) {
            const bf16_t* kr = Z + (size_t)(b * SEQ + s) * LDZ + ZKI;
            float kv[64];
            for (int d = 0; d < 64; ++d) kv[d] = bf2f(kr[d]);
            float sc = 0.f;
            for (int h = 0; h < 16; ++h) { float dot = 0.f; for (int d = 0; d < 64; ++d) dot += q[h * 64 + d] * kv[d]; dot *= 0.125f; sc += (dot > 0.f ? dot : 0.f) * w[h]; }
            const unsigned u = __float_as_uint(sc); k = u ^ ((unsigned)((int)u >> 31) | 0x80000000u);
        }
        keys[s] = k;
    }
    __syncthreads();
    unsigned T = 0u;
    for (int bit = 31; bit >= 0; --bit) {
        const unsigned cand = T | (1u << bit);
        if (tid == 0) cnt = 0u;
        __syncthreads();
        unsigned c = 0u; for (int s = tid; s < SEQ; s += 256) c += keys[s] >= cand ? 1u : 0u;
        atomicAdd(&cnt, c);
        __syncthreads();
        if (cnt >= 256u) T = cand;
        __syncthreads();
    }
    if (T == 0u) T = 1u;
    if (tid < 128) { unsigned word = 0u; for (int j = 0; j < 32; ++j) word |= (keys[tid * 32 + j] >= T ? 1u : 0u) << j; mask[(size_t)row * 128 + tid] = word; }
}
__global__ void __launch_bounds__(256) ref_attention(const bf16_t* Z, const unsigned* mask, const float* rel_bias, bf16_t* YB) {
    const int gw = blockIdx.x * 4 + (threadIdx.x >> 6), lane = threadIdx.x & 63;
    const int row = gw >> 3, h = gw & 7, b = row / SEQ, t = row % SEQ;
    const bf16_t* zr = Z + (size_t)row * LDZ + ZQ + h * 128;
    const float q0 = bf2f(zr[2 * lane]), q1 = bf2f(zr[2 * lane + 1]);
    float m = -1e30f, l = 0.f, a0 = 0.f, a1 = 0.f;
    for (int wi = 0; wi < 128; ++wi) {
        unsigned word = mask[(size_t)row * 128 + wi];
        while (word) {
            const int j = __builtin_ctz(word); word &= word - 1;
            const int s = wi * 32 + j;
            const bf16_t* kr = Z + (size_t)(b * SEQ + s) * LDZ + ZK + h * 128; const bf16_t* vr = Z + (size_t)(b * SEQ + s) * LDZ + ZVV + h * 128;
            float d = q0 * bf2f(kr[2 * lane]) + q1 * bf2f(kr[2 * lane + 1]);
            for (int o = 1; o < 64; o <<= 1) d += __shfl_xor(d, o);
            int n = t - s; if (n < 0) n = 0; int bk = n; if (n >= 16) { bk = 16 + (int)(logf((float)n / 16.f) / 2.0794415416798357f * 16.f); bk = bk > 31 ? 31 : bk; }
            const float lg = d * 0.08838834764831845f + rel_bias[bk * NHEAD + h];
            const float mn = fmaxf(m, lg), al = expf(m - mn), p = expf(lg - mn);
            l = l * al + p; a0 = a0 * al + p * bf2f(vr[2 * lane]); a1 = a1 * al + p * bf2f(vr[2 * lane + 1]); m = mn;
        }
    }
    *(unsigned*)(YB + (size_t)row * 1024 + h * 128 + 2 * lane) = cvt_pk_bf16(a0 / l, a1 / l);
}
#endif

constexpr int PH_PER_LAYER = 14, N_PHASES = PH_PER_LAYER * DEPTH;
__global__ void __launch_bounds__(NWAVES * 64, 2) mk_fwd(Args args) {
    extern __shared__ __attribute__((aligned(16))) unsigned char lds[];
    Frame F;
    F.lds = (LAS unsigned char*)lds;
    F.wave = __builtin_amdgcn_readfirstlane(threadIdx.x >> 6);
    F.G = gridDim.x; { const int bx = blockIdx.x; F.vcu = (F.G % 8 == 0) ? (bx % 8) * (F.G / 8) + bx / 8 : bx; }
    unsigned char* ws = args.ws;
    for (int u = threadIdx.x; u < (LDS_BYTES - LDSCTL_OFF) / 4; u += NWAVES * 64) ((LAS unsigned*)(F.lds + LDSCTL_OFF))[u] = 0u;
    __syncthreads();
    volatile LAS unsigned* MISC = (volatile LAS unsigned*)(F.lds + MISC_OFF);
    XcdBarrier bar; bar.bar = (unsigned*)(ws + WS_CTL) + CW_BAR; bar.x = 0; bar.st = nullptr;
#if MK_N_LAUNCHES == 1
    bar = xcd_barrier_post((unsigned*)(ws + WS_CTL) + CW_BAR, MISC + 8, (int)threadIdx.x);
#define GRID_BAR() do { size_t zb = 0; asm volatile("" : "+s"(zb)); XcdBarrier b2 = bar; b2.bar = bar.bar + zb; b2.x = bar.x + (unsigned)zb; xcd_barrier(b2, frame_tid(F)); } while (0)
#else
#define GRID_BAR() do { } while (0)
#endif
    const int lo = args.ph_lo, hi = args.ph_hi;
#define IN(k) (lo <= (k) && (k) < hi)
#define SEAM(k) do { if (IN(k) && IN((k) + 1)) GRID_BAR(); } while (0)

#define PH_PTRS size_t zl = 0; asm volatile("" : "+s"(zl)); int tz = frame_tid(F); asm volatile("" : "+v"(tz)); unsigned char* wsl = args.ws + zl; \
    bf16_t* Hb = (bf16_t*)(wsl + WS_H); bf16_t* Fb = (bf16_t*)(wsl + WS_F); bf16_t* Zb = (bf16_t*)(wsl + WS_Z); \
    bf16_t* YA = (bf16_t*)(wsl + WS_YA); bf16_t* YB = (bf16_t*)(wsl + WS_YB); unsigned* MASK = (unsigned*)(wsl + WS_MASK); float* X = args.out + zl; bf16_t* XB = (bf16_t*)(wsl + WS_XB); float* RS = (float*)(wsl + WS_RS); \
    (void)Hb; (void)Fb; (void)Zb; (void)YA; (void)YB; (void)MASK; (void)X; (void)XB; (void)RS;

    for (int l = 0; l < DEPTH; ++l) {
        const int pb = PH_PER_LAYER * l;
        if (pb >= hi || pb + PH_PER_LAYER <= lo) continue;
        if (PH_ON(0) && IN(pb + 0)) for (int rep_ = 0; rep_ < PH_REP(0); ++rep_) {
            PH_PTRS
#define MK_LAYERW(L, ll) LayerW L; L.f1i = (args.in[3] + zl) + (size_t)(ll) * DM * NFF; L.f1o = (args.in[4] + zl) + (size_t)(ll) * FF * DM; L.f2i = (args.in[19] + zl) + (size_t)(ll) * DM * NFF; L.f2o = (args.in[20] + zl) + (size_t)(ll) * FF * DM; \
            L.win = (args.in[7] + zl) + (size_t)(ll) * DM * INCOLS; L.wg = (args.in[15] + zl) + (size_t)(ll) * DM * 2 * DM; L.wa = (args.in[13] + zl) + (size_t)(ll) * SGW * DM; L.wb = (args.in[14] + zl) + (size_t)(ll) * 1024 * DM; L.wo = (args.in[16] + zl) + (size_t)(ll) * DM * DM; \
            L.wss = (args.in[10] + zl) + (size_t)(ll) * 8 * 128 * 128; L.g_f1 = (args.in[1] + zl) + (size_t)(ll) * DM; L.g_f2 = (args.in[17] + zl) + (size_t)(ll) * DM; L.g_mix = (args.in[5] + zl) + (size_t)(ll) * DM; \
            L.f8_1 = (F8_MASK >> (2 * (ll))) & 1; L.f8_2 = (F8_MASK >> (2 * (ll) + 1)) & 1; L.q8_1 = (I8_MASK >> (2 * (ll))) & 1; L.q8_2 = (I8_MASK >> (2 * (ll) + 1)) & 1; L.q8_m = (I8_MASK >> (4 + (ll))) & 1;
            if (l == 0) { MK_LAYERW(L, l) conv_phase(F, L, wsl, tz, F.vcu, F.G, 0, CV_S1); conv_phase(F, L, wsl, tz, F.vcu, F.G, CV_S2, CV_END); }
            if (l == 0) thin_phase(F, (args.in[0] + zl), XB, nullptr, nullptr, 0.f, RS, nullptr, ((I8_MASK >> 0) & 1) ? (unsigned char*)Hb : nullptr, tz);
        }
        if (l == 0) SEAM(pb + 0);
        if (PH_ON(1) && IN(pb + 1)) for (int rep_ = 0; rep_ < PH_REP(1); ++rep_) {
            PH_PTRS
            pg8::StaticOrder S; S.init(MT, NFF, F.G, (int)blockIdx.x);
            constexpr bool ANY_I8 = (I8_MASK & 0x5) != 0, ANY_B16 = (~I8_MASK & 0x5) != 0;
            const bool q8 = (I8_MASK >> (2 * l)) & 1, o8 = (F8_MASK >> (2 * l)) & 1;
            if (ANY_I8 && q8) {
                pg8::Gemm g{Hb, (bf16_t*)(wsl + WS_WF1I), MT, NFF, DM};
                if (o8) { pg8::Epi<5, true> E{Zb, FF, nullptr, 0, RS + MT, F8_SG, 1.f / I8_SWQ}; pg8::gemm_phase<pg8::Epi<5, true>, pg8::StaticOrder, true, true, 2>(F.lds, g, S, E, tz); }
                else { pg8::Epi<1, true> E{Zb, FF, nullptr, 0, RS + MT, 1.f, 1.f / I8_SWQ}; pg8::gemm_phase<pg8::Epi<1, true>, pg8::StaticOrder, true, true, 2>(F.lds, g, S, E, tz); }
            } else if (ANY_B16) {
                pg8::Gemm g{XB, (bf16_t*)(wsl + WS_WF1I), MT, NFF, DM};
                if (o8) { pg8::Epi<5> E{Zb, FF, nullptr, 0, RS, F8_SG, 1.f}; pg8::gemm_phase<pg8::Epi<5>, pg8::StaticOrder, true, true>(F.lds, g, S, E, tz); }
                else { pg8::Epi<1> E{Zb, FF, nullptr, 0, RS, 1.f, 1.f}; pg8::gemm_phase<pg8::Epi<1>, pg8::StaticOrder, true, true>(F.lds, g, S, E, tz); }
            }
        }
        SEAM(pb + 1);
        if (PH_ON(2) && IN(pb + 2)) for (int rep_ = 0; rep_ < PH_REP(2); ++rep_) {
            PH_PTRS
            pg8::Gemm g{Zb, (bf16_t*)(wsl + WS_WF1O), MT, DM, FF}; pg8::StaticOrder S; S.init(MT, DM, F.G, (int)blockIdx.x);
            if ((F8_MASK >> (2 * l)) & 1) { pg8::Epi<0> E{Fb, DM, nullptr, 0, nullptr, 1.f / (F8_SG * F8_SW), 1.f}; pg8::gemm_phase<pg8::Epi<0>, pg8::StaticOrder, true, true, 1>(F.lds, g, S, E, tz); }
            else { pg8::Epi<0> E{Fb, DM, nullptr, 0, nullptr, 1.f, 1.f}; pg8::gemm_phase<pg8::Epi<0>, pg8::StaticOrder, true, true>(F.lds, g, S, E, tz); }
        }
        SEAM(pb + 2);
        if (PH_ON(3) && IN(pb + 3)) for (int rep_ = 0; rep_ < PH_REP(3); ++rep_) { PH_PTRS thin_phase(F, nullptr, XB, Fb, (args.in[2] + zl) + (size_t)l * DM, 0.5f, RS, nullptr, ((I8_MASK >> (4 + l)) & 1) ? (unsigned char*)Hb : nullptr, tz); }
        SEAM(pb + 3);
        if (PH_ON(4) && IN(pb + 4)) for (int rep_ = 0; rep_ < PH_REP(4); ++rep_) {
            PH_PTRS
            pg8::StaticOrder S; S.init(MT, LDZ, F.G, (int)blockIdx.x);
            constexpr bool ANY_I8 = (I8_MASK & 0x30) != 0, ANY_B16 = (~I8_MASK & 0x30) != 0;
            if (ANY_I8 && ((I8_MASK >> (4 + l)) & 1)) { pg8::Gemm g{Hb, (bf16_t*)(wsl + WS_WMIX), MT, LDZ, DM}; pg8::Epi<2, true> E{Zb, LDZ, Fb, 0, RS + MT, 1.f, 1.f / I8_SWQ}; pg8::gemm_phase<pg8::Epi<2, true>, pg8::StaticOrder, true, true, 2>(F.lds, g, S, E, tz); }
            else if (ANY_B16) { pg8::Gemm g{XB, (bf16_t*)(wsl + WS_WMIX), MT, LDZ, DM}; pg8::Epi<2> E{Zb, LDZ, Fb, 0, RS, 1.f, 1.f}; pg8::gemm_phase<pg8::Epi<2>, pg8::StaticOrder, true, true>(F.lds, g, S, E, tz); }
            constexpr int BUSY = (MT / 256) * (LDZ / 256) % 256;
            if (BUSY != 0 && (int)blockIdx.x >= BUSY && F.G == 256) {
                { MK_LAYERW(L2, l) conv_phase(F, L2, wsl, tz, (int)blockIdx.x - BUSY, 256 - BUSY, CV_S1, CV_S2); }
            } else if (F.G != 256 || BUSY == 0) {
                { MK_LAYERW(L2, l) conv_phase(F, L2, wsl, tz, F.vcu, F.G, CV_S1, CV_S2); }
            }
        }
        SEAM(pb + 4);
        if (PH_ON(5) && IN(pb + 5)) for (int rep_ = 0; rep_ < PH_REP(5); ++rep_) {
            PH_PTRS
#ifndef NO_IDX
            for (int rep2_ = 0; rep2_ < DUP_IDX; ++rep2_)
            for (int u = F.vcu; u < 1024; u += F.G) {
                const int i = u >> 8, c = u & 255; const int jj = (c + 128 * (i >> 1)) & 255; const int j = (i & 1) ? 255 - jj : jj;
                indexer_unit(F.lds, Zb, MASK, i, 16 * j, F.wave, tz);
            }
#endif
            const float* lng = (args.in[8] + zl) + (size_t)l * SGW; const float* lnb = (args.in[9] + zl) + (size_t)l * SGW;
            const bf16_t* wsb = (const bf16_t*)(wsl + WS_WSB); const float* bss = (args.in[11] + zl) + (size_t)l * 8 * 128;
            for (int rep3_ = 0; rep3_ < DUP_SGU; ++rep3_)
            for (int u = F.vcu; u < 256; u += F.G) sgu_unit(F, Zb, YA, lng, lnb, wsb, bss, u >> 6, (u >> 1) & 31, u & 1, tz);
        }
        SEAM(pb + 5);
        if (PH_ON(6) && IN(pb + 6)) for (int rep_ = 0; rep_ < PH_REP(6); ++rep_) {
            PH_PTRS
            for (int it = F.vcu; it < 256; it += F.G) {
                const int b = it >> 6, h = (it >> 3) & 7, x = it & 7;
                att::attn_item((char*)lds, (LAS char*)F.lds, Zb, Fb, MASK, (args.in[12] + zl), YB, b, h, x, frame_tid(F));
            }
            __syncthreads();
        }
        SEAM(pb + 6);
        if (PH_ON(7) && IN(pb + 7)) for (int rep_ = 0; rep_ < PH_REP(7); ++rep_) {
            PH_PTRS
            pg8::Gemm g{YA, (bf16_t*)(wsl + WS_WA), MT, DM, SGW}; pg8::StaticOrder S; S.init(MT, DM, F.G, (int)blockIdx.x);
            pg8::Epi<3> E{Hb, DM, Zb + ZG, LDZ, nullptr, 1.f, 1.f};
            pg8::gemm_phase<pg8::Epi<3>, pg8::StaticOrder, true, true>(F.lds, g, S, E, tz);
        }
        if (PH_ON(8) && IN(pb + 8)) for (int rep_ = 0; rep_ < PH_REP(8); ++rep_) {
            PH_PTRS
            pg8::Gemm g{YB, (bf16_t*)(wsl + WS_WB), MT, DM, 1024}; pg8::StaticOrder S; S.init(MT, DM, F.G, (int)blockIdx.x);
            pg8::Epi<4> E{Hb, DM, Zb + ZG + DM, LDZ, nullptr, 1.f, 1.f};
            pg8::gemm_phase<pg8::Epi<4>, pg8::StaticOrder, true, true>(F.lds, g, S, E, tz);
        }
        SEAM(pb + 8);
        if (PH_ON(9) && IN(pb + 9)) for (int rep_ = 0; rep_ < PH_REP(9); ++rep_) {
            PH_PTRS
            pg8::Gemm g{Hb, (bf16_t*)(wsl + WS_WO), MT, DM, DM}; pg8::StaticOrder S; S.init(MT, DM, F.G, (int)blockIdx.x);
            pg8::Epi<0> E{Fb, DM, nullptr, 0, nullptr, 1.f, 1.f};
            pg8::gemm_phase<pg8::Epi<0>, pg8::StaticOrder, true, true>(F.lds, g, S, E, tz);
        }
        SEAM(pb + 9);
        if (PH_ON(10) && IN(pb + 10)) for (int rep_ = 0; rep_ < PH_REP(10); ++rep_) { PH_PTRS thin_phase(F, nullptr, XB, Fb, (args.in[6] + zl) + (size_t)l * DM, 1.0f, RS, nullptr, ((I8_MASK >> (2 * l + 1)) & 1) ? (unsigned char*)Hb : nullptr, tz); }
        SEAM(pb + 10);
        if (PH_ON(11) && IN(pb + 11)) for (int rep_ = 0; rep_ < PH_REP(11); ++rep_) {
            PH_PTRS
            pg8::StaticOrder S; S.init(MT, NFF, F.G, (int)blockIdx.x);
            constexpr bool ANY_I8 = (I8_MASK & 0xA) != 0, ANY_B16 = (~I8_MASK & 0xA) != 0;
            const bool q8 = (I8_MASK >> (2 * l + 1)) & 1, o8 = (F8_MASK >> (2 * l + 1)) & 1;
            if (ANY_I8 && q8) {
                pg8::Gemm g{Hb, (bf16_t*)(wsl + WS_WF2I), MT, NFF, DM};
                if (o8) { pg8::Epi<5, true> E{Zb, FF, nullptr, 0, RS + MT, F8_SG, 1.f / I8_SWQ}; pg8::gemm_phase<pg8::Epi<5, true>, pg8::StaticOrder, true, true, 2>(F.lds, g, S, E, tz); }
                else { pg8::Epi<1, true> E{Zb, FF, nullptr, 0, RS + MT, 1.f, 1.f / I8_SWQ}; pg8::gemm_phase<pg8::Epi<1, true>, pg8::StaticOrder, true, true, 2>(F.lds, g, S, E, tz); }
            } else if (ANY_B16) {
                pg8::Gemm g{XB, (bf16_t*)(wsl + WS_WF2I), MT, NFF, DM};
                if (o8) { pg8::Epi<5> E{Zb, FF, nullptr, 0, RS, F8_SG, 1.f}; pg8::gemm_phase<pg8::Epi<5>, pg8::StaticOrder, true, true>(F.lds, g, S, E, tz); }
                else { pg8::Epi<1> E{Zb, FF, nullptr, 0, RS, 1.f, 1.f}; pg8::gemm_phase<pg8::Epi<1>, pg8::StaticOrder, true, true>(F.lds, g, S, E, tz); }
            }
        }
        SEAM(pb + 11);
        if (PH_ON(12) && IN(pb + 12)) for (int rep_ = 0; rep_ < PH_REP(12); ++rep_) {
            PH_PTRS
            pg8::Gemm g{Zb, (bf16_t*)(wsl + WS_WF2O), MT, DM, FF}; pg8::StaticOrder S; S.init(MT, DM, F.G, (int)blockIdx.x);
            if ((F8_MASK >> (2 * l + 1)) & 1) { pg8::Epi<0> E{Fb, DM, nullptr, 0, nullptr, 1.f / (F8_SG * F8_SW), 1.f}; pg8::gemm_phase<pg8::Epi<0>, pg8::StaticOrder, true, true, 1>(F.lds, g, S, E, tz); }
            else { pg8::Epi<0> E{Fb, DM, nullptr, 0, nullptr, 1.f, 1.f}; pg8::gemm_phase<pg8::Epi<0>, pg8::StaticOrder, true, true>(F.lds, g, S, E, tz); }
        }
        SEAM(pb + 12);
        if (PH_ON(13) && IN(pb + 13)) for (int rep_ = 0; rep_ < PH_REP(13); ++rep_) { PH_PTRS thin_phase(F, nullptr, XB, Fb, (args.in[18] + zl) + (size_t)l * DM, 0.5f, RS, (l + 1 < DEPTH) ? nullptr : X, (l + 1 < DEPTH && ((I8_MASK >> (2 * l + 2)) & 1)) ? (unsigned char*)Hb : nullptr, tz);
            if (l + 1 < DEPTH) { MK_LAYERW(LN, l + 1) conv_phase(F, LN, wsl, tz, F.vcu, F.G, 0, CV_S1); conv_phase(F, LN, wsl, tz, F.vcu, F.G, CV_S2, CV_END); } }
        SEAM(pb + 13);
    }
#undef IN
#undef SEAM
}

extern "C" void kernel_launch(void* const* d_in, const int* in_sizes, int n_in, void* d_out, int out_size, void* d_ws, size_t ws_size, hipStream_t stream) {
    static int grid = 0;
    if (grid == 0) {
        if (n_in != 21 || out_size != MT * DM || ws_size < WS_END) { fprintf(stderr, "kernel_launch: unexpected shapes (n_in %d out %d ws %zu, need %zu)\n", n_in, out_size, ws_size, (size_t)WS_END); grid = -1; return; }
        int dev = 0, cus = 0, per_cu = 0;
        if (hipGetDevice(&dev) != hipSuccess || hipDeviceGetAttribute(&cus, hipDeviceAttributeMultiprocessorCount, dev) != hipSuccess) { grid = -1; return; }
        if (hipFuncSetAttribute((const void*)mk_fwd, hipFuncAttributeMaxDynamicSharedMemorySize, LDS_BYTES) != hipSuccess) { fprintf(stderr, "kernel_launch: hipFuncSetAttribute failed\n"); grid = -1; return; }
        if (hipOccupancyMaxActiveBlocksPerMultiprocessor(&per_cu, (const void*)mk_fwd, NWAVES * 64, LDS_BYTES) != hipSuccess || per_cu < 1) { fprintf(stderr, "kernel_launch: occupancy query says %d\n", per_cu); }
        (void)hipGetLastError();
        grid = cus;
    }
    if (grid < 0) return;
    (void)hipMemsetAsync((char*)d_ws + WS_CTL, 0, CTL_BYTES, stream);
    Args a{};
    for (int i = 0; i < 21; ++i) a.in[i] = (const float*)d_in[i];
    a.out = (float*)d_out; a.ws = (unsigned char*)d_ws;
#if MK_N_LAUNCHES == 1
    a.ph_lo = 0; a.ph_hi = N_PHASES;
    hipLaunchKernelGGL(mk_fwd, dim3(grid), dim3(NWAVES * 64), LDS_BYTES, stream, a);
#else
    for (int p = 0; p < N_PHASES; ++p) { a.ph_lo = p; a.ph_hi = p + 1; hipLaunchKernelGGL(mk_fwd, dim3(grid), dim3(NWAVES * 64), LDS_BYTES, stream, a);
#ifdef REF_IDX
        if (p % PH_PER_LAYER == 5) hipLaunchKernelGGL(ref_indexer, dim3(MT), dim3(256), 0, stream, (const bf16_t*)((char*)d_ws + WS_Z), (unsigned*)((char*)d_ws + WS_MASK));
#endif
#ifdef REF_ATT
        if (p % PH_PER_LAYER == 6) hipLaunchKernelGGL(ref_attention, dim3(MT * 8 / 4), dim3(256), 0, stream, (const bf16_t*)((char*)d_ws + WS_Z), (const unsigned*)((char*)d_ws + WS_MASK), (const float*)d_in[12], (bf16_t*)((char*)d_ws + WS_YB));
#endif
    }
#endif
}
```
